# Optimizing an MI355X kernel written in HIP

```python
import math
import jax
import jax.numpy as jnp
from jax import lax
import numpy as np

D_MODEL = 1024
BATCH = 4
SEQ = 4096
DEPTH = 2

GRID_W = 64
CTX_LEN = 256
EPS = 1e-6
D_MIX = D_MODEL
D_FF = 4 * D_MODEL
N_MOD = 6

S5_WIDTH = D_MIX // 4
S5_GROUP = 16
S5_GROUPS = S5_WIDTH // S5_GROUP
S5_STATE = 64

GDN_HEAD = 64
GDN_HEADS = (D_MIX - S5_WIDTH) // (2 * GDN_HEAD)
GDN_WIDTH = GDN_HEADS * GDN_HEAD
GDN_CONV = 5
GDN_CHUNK = 64

RWKV_HEAD = 64
RWKV_WIDTH = D_MIX - S5_WIDTH - GDN_WIDTH
RWKV_HEADS = RWKV_WIDTH // RWKV_HEAD
DECAY_LORA = 64
ICLR_LORA = 64
GATE_LORA = 128
RWKV_GN_EPS = 64e-5

S5_COLS = S5_WIDTH
GDN_COLS = 4 * GDN_WIDTH + 4 * GDN_HEADS
RWKV_COLS = 3 * RWKV_WIDTH + 2 * DECAY_LORA + 2 * ICLR_LORA + GATE_LORA
IN_COLS = S5_COLS + GDN_COLS + RWKV_COLS

kernel_name = 'hybrid_s5_gdn_rwkv7_prefix_dit'

f32 = jnp.float32


def to_heads(t, n):
    return t.reshape(t.shape[:-1] + (n, t.shape[-1] // n))


def rmsnorm(t, gain):
    t = t.astype(f32)
    return t * lax.rsqrt(jnp.mean(t * t, axis=-1, keepdims=True) + EPS) * gain.astype(f32)


def l2norm(t):
    return t * lax.rsqrt(jnp.sum(t * t, axis=-1, keepdims=True) + EPS)


def sq_relu_mlp(h, w1, w2):
    return jnp.square(jax.nn.relu(h @ w1)) @ w2


def centred_dwconv(t, w):
    pad = w.shape[0] // 2
    return lax.conv_general_dilated(t, w[:, None, :].astype(t.dtype), window_strides=(1,), padding=[(pad, pad)], dimension_numbers=('NWC', 'WIO', 'NWC'), feature_group_count=t.shape[-1])


def grid_qshift(t):
    B, L, C = t.shape
    rows = L // GRID_W
    gp = jnp.pad(t.reshape(B, rows, GRID_W, C), ((0, 0), (1, 1), (1, 1), (0, 0)))
    left, right = gp[:, 1:-1, :-2], gp[:, 1:-1, 2:]
    up, down = gp[:, :-2, 1:-1], gp[:, 2:, 1:-1]
    d = jnp.arange(C) % 4
    out = jnp.where(d == 0, left, jnp.where(d == 1, right, jnp.where(d == 2, up, down)))
    return out.reshape(B, L, C)


def seq_shift(t):
    tp = jnp.pad(t, ((0, 0), (1, 1), (0, 0)))
    even = jnp.arange(t.shape[-1]) % 2 == 0
    return jnp.where(even, tp[:, :-2], tp[:, 2:])


def _linear_op(e1, e2):
    a1, b1 = e1
    a2, b2 = e2
    return a2 * a1, a2 * b1 + b2


def s5_discretise(a_re, a_im, log_dt):
    A = lax.complex(a_re.astype(f32), a_im.astype(f32))
    dt = jnp.exp(log_dt.astype(f32))[:, None]
    a_bar = jnp.exp(A * dt)
    return a_bar, (a_bar - 1.0) / A


def s5_scan(a_bar, bu, h0, reverse):
    if h0 is not None:
        edge = -1 if reverse else 0
        bu = bu.at[:, edge].add(a_bar * h0)
    a = jnp.broadcast_to(a_bar, bu.shape)
    _, h = lax.associative_scan(_linear_op, (a, bu), reverse=reverse, axis=1)
    return h


def s5_mixer(u_ctx, u_lat, b_re, b_im, c_re, c_im, d, a_re, a_im, log_dt, glu_w, glu_b, ctx_out):
    b_re, b_im, c_re, c_im = (t.astype(f32) for t in (b_re, b_im, c_re, c_im))
    (abar_f, coef_f), (abar_b, coef_b) = (s5_discretise(a_re[i], a_im[i], log_dt[i]) for i in range(2))

    def drive(u, coef):
        ug = to_heads(u, S5_GROUPS)
        bu = lax.complex(jnp.einsum('gpc,blgc->blgp', b_re, ug), jnp.einsum('gpc,blgc->blgp', b_im, ug))
        return coef * bu

    def readout(h, u):
        ug = to_heads(u, S5_GROUPS)
        y = (jnp.einsum('gcp,blgp->blgc', c_re, jnp.real(h)) - jnp.einsum('gcp,blgp->blgc', c_im, jnp.imag(h)) + to_heads(d, S5_GROUPS) * ug)
        z = jax.nn.gelu(y.reshape(u.shape))
        return z * jax.nn.sigmoid(z @ glu_w + glu_b)

    hc_f = s5_scan(abar_f, drive(u_ctx, coef_f), None, False)
    hc_b = s5_scan(abar_b, drive(u_ctx, coef_b), None, True)
    hl_f = s5_scan(abar_f, drive(u_lat, coef_f), hc_f[:, -1], False)
    hl_b = s5_scan(abar_b, drive(u_lat, coef_b), hc_b[:, 0], True)
    y_lat = readout(hl_f + hl_b, u_lat)
    y_ctx = readout(hc_f + hc_b, u_ctx) if ctx_out else None
    return y_ctx, y_lat


def chunk_gated_delta(q, k, v, g, beta, s0, emit):
    B, L, H, K = q.shape
    V = v.shape[-1]
    C = GDN_CHUNK
    N = L // C

    def chunks(t):
        return jnp.moveaxis(t.reshape((B, N, C) + t.shape[2:]), 3, 1)

    q, k, v, beta = chunks(q), chunks(k), chunks(v), chunks(beta)
    g = jnp.cumsum(chunks(g), axis=-1)
    causal = jnp.tril(jnp.ones((C, C), bool))
    strict = jnp.tril(jnp.ones((C, C), bool), k=-1)
    decay = jnp.exp(jnp.where(causal, g[..., :, None] - g[..., None, :], -jnp.inf))
    kb = k * beta[..., None]
    m = jnp.where(strict, jnp.einsum('bhnik,bhnjk->bhnij', kb, k) * decay, 0.0)
    rhs = jnp.concatenate([v * beta[..., None], kb * jnp.exp(g)[..., None]], axis=-1)
    sol = lax.linalg.triangular_solve(m + jnp.eye(C, dtype=m.dtype), rhs, left_side=True, lower=True, unit_diagonal=True)
    u, w = sol[..., :V], sol[..., V:]
    g_last = g[..., -1]
    kd = k * jnp.exp(g_last[..., None] - g)[..., None]
    to_front = lambda t: jnp.moveaxis(t, 2, 0)
    if emit:
        qg = q * jnp.exp(g)[..., None]
        attn = jnp.einsum('bhnik,bhnjk->bhnij', q, k) * decay
        xs = tuple(to_front(t) for t in (kd, u, w, g_last, qg, attn))
    else:
        xs = tuple(to_front(t) for t in (kd, u, w, g_last))

    def step(s, inp):
        kd_n, u_n, w_n, gl_n = inp[:4]
        v_new = u_n - jnp.einsum('bhck,bhkv->bhcv', w_n, s)
        s_next = s * jnp.exp(gl_n)[..., None, None] + jnp.einsum('bhck,bhcv->bhkv', kd_n, v_new)
        if emit:
            qg_n, attn_n = inp[4:]
            o = jnp.einsum('bhck,bhkv->bhcv', qg_n, s) + jnp.einsum('bhij,bhjv->bhiv', attn_n, v_new)
            return s_next, o
        return s_next, None

    s_final, o = lax.scan(step, s0, xs)
    if emit:
        o = jnp.moveaxis(jnp.moveaxis(o, 0, 2), 1, 3).reshape(B, L, H, V)
    return o, s_final


def gdn_prep(p, conv_w, a_log, dt_bias):
    W, H = GDN_WIDTH, GDN_HEADS
    qkv = jax.nn.silu(centred_dwconv(p[..., :3 * W], conv_w))
    q = l2norm(to_heads(qkv[..., :W], H)) * GDN_HEAD ** -0.5
    k = l2norm(to_heads(qkv[..., W:2 * W], H))
    v = to_heads(qkv[..., 2 * W:], H)
    z = to_heads(p[..., 3 * W:4 * W], H)
    beta = jax.nn.sigmoid(to_heads(p[..., 4 * W:4 * W + 2 * H], 2))
    g = -jnp.exp(a_log) * jax.nn.softplus(to_heads(p[..., 4 * W + 2 * H:], 2) + dt_bias)
    return q, k, v, z, beta, g


def gdn_mixer(p_ctx, p_lat, conv_w, a_log, dt_bias, norm_w, ctx_out):
    qc, kc, vc, zc, bc, gc = gdn_prep(p_ctx, conv_w, a_log, dt_bias)
    ql, kl, vl, zl, bl, gl = gdn_prep(p_lat, conv_w, a_log, dt_bias)
    s0 = jnp.zeros((p_lat.shape[0], GDN_HEADS, GDN_HEAD, GDN_HEAD), f32)
    rev = lambda t: jnp.flip(t, axis=1)
    oc_f, sc_f = chunk_gated_delta(qc, kc, vc, gc[:, :, 0], bc[:, :, 0], s0, ctx_out)
    oc_b, sc_b = chunk_gated_delta(rev(qc), rev(kc), rev(vc), rev(gc[:, :, 1]), rev(bc[:, :, 1]), s0, ctx_out)
    ol_f, _ = chunk_gated_delta(ql, kl, vl, gl[:, :, 0], bl[:, :, 0], sc_f, True)
    ol_b, _ = chunk_gated_delta(rev(ql), rev(kl), rev(vl), rev(gl[:, :, 1]), rev(bl[:, :, 1]), sc_b, True)

    def readout(o, z):
        return (rmsnorm(o, norm_w) * jax.nn.silu(z)).reshape(z.shape[0], z.shape[1], GDN_WIDTH)

    y_lat = readout(ol_f + rev(ol_b), zl)
    y_ctx = readout(oc_f + rev(oc_b), zc) if ctx_out else None
    return y_ctx, y_lat


def rwkv_prep(p, shifted, mu, w0, w_up, a0, a_up, k_k, k_a):
    B, L, _ = p.shape
    W, H = RWKV_WIDTH, RWKV_HEADS
    p = p + (shifted - p) * mu
    r, k, v = p[..., :W], p[..., W:2 * W], p[..., 2 * W:3 * W]
    o1 = 3 * W
    o2 = o1 + 2 * DECAY_LORA
    o3 = o2 + 2 * ICLR_LORA
    w_dn = p[..., o1:o2].reshape(B, L, 2, DECAY_LORA)
    a_dn = p[..., o2:o3].reshape(B, L, 2, ICLR_LORA)
    g_dn = p[..., o3:]
    w_log = -jax.nn.softplus(-(w0 + jnp.einsum('bldr,drw->bldw', jnp.tanh(w_dn), w_up))) - 0.5
    decay = jnp.exp(-jnp.exp(w_log))
    iclr = jax.nn.sigmoid(a0 + jnp.einsum('bldr,drw->bldw', a_dn, a_up))
    kk = l2norm(to_heads(k * k_k, H))
    k_dir = k[:, :, None, :] * (1.0 + (iclr - 1.0) * k_a)
    b_dir = kk.reshape(B, L, 1, W) * iclr
    heads = lambda t: to_heads(t, H)
    return heads(r), heads(v), kk, heads(decay), heads(k_dir), heads(b_dir), g_dn


def rwkv7_scan(r, decay, k, v, kk, b, s0, reverse, emit):
    def step(s, inp):
        r_t, w_t, k_t, v_t, kk_t, b_t = inp
        sa = jnp.einsum('bhvk,bhk->bhv', s, kk_t)
        s = s * w_t[:, :, None, :] - sa[..., None] * b_t[:, :, None, :] + v_t[..., None] * k_t[:, :, None, :]
        return s, (jnp.einsum('bhvk,bhk->bhv', s, r_t) if emit else None)

    xs = tuple(jnp.moveaxis(t, 1, 0) for t in (r, decay, k, v, kk, b))
    s_final, y = lax.scan(step, s0, xs, reverse=reverse)
    return (jnp.moveaxis(y, 0, 1) if emit else None), s_final


def rwkv_mixer(p_ctx, p_lat, mu, w0, w_up, a0, a_up, g_up, k_k, k_a, r_k, ln_w, ln_b, ctx_out):
    args = (mu, w0, w_up, a0, a_up, k_k, k_a)
    ctx_t = rwkv_prep(p_ctx, seq_shift(p_ctx), *args)
    lat_t = rwkv_prep(p_lat, grid_qshift(p_lat), *args)
    s0 = jnp.zeros((p_lat.shape[0], RWKV_HEADS, RWKV_HEAD, RWKV_HEAD), f32)

    def bidir(t, s0_f, s0_b, emit):
        r, v, kk, decay, k_dir, b_dir, _ = t
        y_f, s_f = rwkv7_scan(r, decay[:, :, 0], k_dir[:, :, 0], v, kk, b_dir[:, :, 0], s0_f, False, emit)
        y_b, s_b = rwkv7_scan(r, decay[:, :, 1], k_dir[:, :, 1], v, kk, b_dir[:, :, 1], s0_b, True, emit)
        return y_f, y_b, s_f, s_b

    def readout(y, t):
        r, v, _, _, k_dir, _, g_dn = t
        B, L = y.shape[:2]
        mean = jnp.mean(y, axis=-1, keepdims=True)
        var = jnp.mean(jnp.square(y - mean), axis=-1, keepdims=True)
        yn = ((y - mean) * lax.rsqrt(var + RWKV_GN_EPS)).reshape(B, L, RWKV_WIDTH) * ln_w + ln_b
        bonus = jnp.sum(r[:, :, None] * k_dir * r_k, axis=(2, 4))[..., None] * v
        gate = jax.nn.sigmoid(g_dn) @ g_up
        return (yn + bonus.reshape(B, L, RWKV_WIDTH)) * gate

    yc_f, yc_b, sc_f, sc_b = bidir(ctx_t, s0, s0, ctx_out)
    yl_f, yl_b, _, _ = bidir(lat_t, sc_f, sc_b, True)
    y_lat = readout(yl_f + yl_b, lat_t)
    y_ctx = readout(yc_f + yc_b, ctx_t) if ctx_out else None
    return y_ctx, y_lat


def setup_inputs(seed: int = 0) -> dict:
    key = jax.random.key(seed)
    ks = iter(jax.random.split(key, 64))

    def nrm(shape, scale):
        return scale * jax.random.normal(next(ks), shape, f32)

    def unif(shape, lo, hi):
        return jax.random.uniform(next(ks), shape, f32, lo, hi)

    G, P, H = S5_GROUPS, S5_STATE, GDN_HEADS
    gdn_dt = unif((DEPTH, 2, H), 1e-3, 1e-1)
    return {
        'x': nrm((BATCH, SEQ, D_MODEL), 1.0),
        'c': nrm((BATCH, D_MODEL), 1.0),
        'ctx': nrm((BATCH, CTX_LEN, D_MODEL), 1.0),
        'c_ctx': nrm((D_MODEL,), 1.0),
        'mod_w': nrm((DEPTH, D_MODEL, N_MOD * D_MODEL), 0.5 * D_MODEL ** -0.5),
        'mod_b': nrm((DEPTH, N_MOD * D_MODEL), 0.01),
        'norm_mix': 1.0 + nrm((DEPTH, D_MODEL), 0.02),
        'norm_mlp': 1.0 + nrm((DEPTH, D_MODEL), 0.02),
        'norm_final': 1.0 + nrm((D_MODEL,), 0.02),
        'w_in': nrm((DEPTH, D_MODEL, IN_COLS), D_MODEL ** -0.5),
        'w_out': nrm((DEPTH, D_MIX, D_MODEL), D_MIX ** -0.5),
        's5_b_re': nrm((DEPTH, G, P, S5_GROUP), (2 * S5_GROUP) ** -0.5),
        's5_b_im': nrm((DEPTH, G, P, S5_GROUP), (2 * S5_GROUP) ** -0.5),
        's5_c_re': nrm((DEPTH, G, S5_GROUP, P), P ** -0.5),
        's5_c_im': nrm((DEPTH, G, S5_GROUP, P), P ** -0.5),
        's5_d': nrm((DEPTH, S5_WIDTH), 0.5),
        's5_a_re': -0.5 + nrm((DEPTH, 2, G, P), 0.01),
        's5_a_im': jnp.pi * jnp.arange(P, dtype=f32) + nrm((DEPTH, 2, G, P), 0.01),
        's5_log_dt': unif((DEPTH, 2, G), math.log(1e-3), math.log(1e-1)),
        's5_glu_w': nrm((DEPTH, S5_WIDTH, S5_WIDTH), S5_WIDTH ** -0.5),
        's5_glu_b': nrm((DEPTH, S5_WIDTH), 0.01),
        'gdn_conv': nrm((DEPTH, GDN_CONV, 3 * GDN_WIDTH), GDN_CONV ** -0.5),
        'gdn_a_log': jnp.log(unif((DEPTH, 2, H), 1.0, 16.0)),
        'gdn_dt_bias': gdn_dt + jnp.log(-jnp.expm1(-gdn_dt)),
        'gdn_norm': 1.0 + nrm((DEPTH, GDN_HEAD), 0.02),
        'rwkv_mu': unif((DEPTH, RWKV_COLS), 0.0, 1.0),
        'rwkv_w0': unif((DEPTH, 2, RWKV_WIDTH), -5.0, 1.0),
        'rwkv_w_up': nrm((DEPTH, 2, DECAY_LORA, RWKV_WIDTH), 0.1),
        'rwkv_a0': nrm((DEPTH, 2, RWKV_WIDTH), 0.1),
        'rwkv_a_up': nrm((DEPTH, 2, ICLR_LORA, RWKV_WIDTH), 0.1),
        'rwkv_g_up': nrm((DEPTH, GATE_LORA, RWKV_WIDTH), GATE_LORA ** -0.5),
        'rwkv_k_k': 0.85 + nrm((DEPTH, RWKV_WIDTH), 0.02),
        'rwkv_k_a': 1.0 + nrm((DEPTH, RWKV_WIDTH), 0.02),
        'rwkv_r_k': nrm((DEPTH, RWKV_HEADS, RWKV_HEAD), 0.1),
        'rwkv_ln_w': 1.0 + nrm((DEPTH, RWKV_WIDTH), 0.02),
        'rwkv_ln_b': nrm((DEPTH, RWKV_WIDTH), 0.01),
        'mlp_w1': nrm((DEPTH, D_MODEL, D_FF), D_MODEL ** -0.5),
        'mlp_w2': nrm((DEPTH, D_FF, D_MODEL), D_FF ** -0.5),
    }


def reference(x, c, ctx, c_ctx, mod_w, mod_b, norm_mix, norm_mlp, norm_final, w_in, w_out,
              s5_b_re, s5_b_im, s5_c_re, s5_c_im, s5_d, s5_a_re, s5_a_im, s5_log_dt, s5_glu_w, s5_glu_b,
              gdn_conv, gdn_a_log, gdn_dt_bias, gdn_norm,
              rwkv_mu, rwkv_w0, rwkv_w_up, rwkv_a0, rwkv_a_up, rwkv_g_up, rwkv_k_k, rwkv_k_a, rwkv_r_k,
              rwkv_ln_w, rwkv_ln_b, mlp_w1, mlp_w2):
    o_gdn = S5_COLS
    o_rwkv = S5_COLS + GDN_COLS
    for layer in range(DEPTH):
        ctx_out = layer < DEPTH - 1
        mods = jax.nn.silu(c.astype(f32)) @ mod_w[layer] + mod_b[layer]
        sh1, sc1, gt1, sh2, sc2, gt2 = jnp.split(mods[:, None, :], N_MOD, axis=-1)
        cmods = jnp.split(jax.nn.silu(c_ctx.astype(f32)) @ mod_w[layer] + mod_b[layer], N_MOD)

        p_lat = (rmsnorm(x, norm_mix[layer]) * (1.0 + sc1) + sh1) @ w_in[layer]
        p_ctx = (rmsnorm(ctx, norm_mix[layer]) * (1.0 + cmods[1]) + cmods[0]) @ w_in[layer]
        ya_c, ya_l = s5_mixer(p_ctx[..., :o_gdn], p_lat[..., :o_gdn], s5_b_re[layer], s5_b_im[layer],
                              s5_c_re[layer], s5_c_im[layer], s5_d[layer], s5_a_re[layer], s5_a_im[layer],
                              s5_log_dt[layer], s5_glu_w[layer], s5_glu_b[layer], ctx_out)
        yb_c, yb_l = gdn_mixer(p_ctx[..., o_gdn:o_rwkv], p_lat[..., o_gdn:o_rwkv], gdn_conv[layer],
                               gdn_a_log[layer], gdn_dt_bias[layer], gdn_norm[layer], ctx_out)
        yc_c, yc_l = rwkv_mixer(p_ctx[..., o_rwkv:], p_lat[..., o_rwkv:], rwkv_mu[layer], rwkv_w0[layer],
                                rwkv_w_up[layer], rwkv_a0[layer], rwkv_a_up[layer], rwkv_g_up[layer],
                                rwkv_k_k[layer], rwkv_k_a[layer], rwkv_r_k[layer], rwkv_ln_w[layer],
                                rwkv_ln_b[layer], ctx_out)
        x = x + gt1 * (jnp.concatenate([ya_l, yb_l, yc_l], axis=-1) @ w_out[layer])

        h = rmsnorm(x, norm_mlp[layer]) * (1.0 + sc2) + sh2
        x = x + gt2 * sq_relu_mlp(h, mlp_w1[layer], mlp_w2[layer])

        if ctx_out:
            ctx = ctx + cmods[2] * (jnp.concatenate([ya_c, yb_c, yc_c], axis=-1) @ w_out[layer])
            hc = rmsnorm(ctx, norm_mlp[layer]) * (1.0 + cmods[4]) + cmods[3]
            ctx = ctx + cmods[5] * sq_relu_mlp(hc, mlp_w1[layer], mlp_w2[layer])
    return rmsnorm(x, norm_final)
```

```cpp
#include <hip/hip_runtime.h>
#include <hip/hip_cooperative_groups.h>
#include <cstdio>
namespace cg = cooperative_groups;

typedef _Float16 hf;
typedef _Float16 h8 __attribute__((ext_vector_type(8)));
typedef _Float16 h4 __attribute__((ext_vector_type(4)));
typedef _Float16 h2 __attribute__((ext_vector_type(2)));
typedef float f32x4 __attribute__((ext_vector_type(4)));
typedef float f32x2 __attribute__((ext_vector_type(2)));
#define LAS __attribute__((address_space(3)))

constexpr int NB = 4, LCTX = 256, TPB = 4352, NTOK = NB * TPB, DM = 1024, DFF = 4096;
constexpr int PP = 3584;
constexpr int NCH16 = 272, NCH64 = 68;
constexpr int NWG = 256, NWAVES = NWG * 8;
constexpr int PC_S5 = 0, PC_GQ = 256, PC_GK = 640, PC_GV = 1024, PC_GZ = 1408, PC_BETA = 1792, PC_A = 1804, PC_RW = 2048;
constexpr int PC_EF = 2048, PC_AF = 2816;

constexpr size_t SZ_WIN = (size_t)PP * DM * 2, SZ_WOUT = (size_t)DM * DM * 2, SZ_W1 = (size_t)DFF * DM * 2, SZ_W2 = SZ_W1;
constexpr size_t OFF_WIN = 0, OFF_WOUT = OFF_WIN + SZ_WIN, OFF_W1 = OFF_WOUT + SZ_WOUT, OFF_W2 = OFF_W1 + SZ_W1;
constexpr size_t SZ_GLUT = 256 * 256 * 2, SZ_WUPT = 2 * 384 * 64 * 2, SZ_GUPT = 384 * 128 * 2, SZ_SMALL = SZ_GLUT + 2 * SZ_WUPT + SZ_GUPT;
constexpr size_t OFF_SMALL = OFF_W2 + SZ_W2;
constexpr size_t SZ_S5W1 = 16 * 256 * 256 * 2, SZ_S5W2 = 16 * 256 * 512 * 2, SZ_KD = 2 * 16 * 16 * 256 * 4;
constexpr size_t OFF_S5W1 = OFF_SMALL + 2 * SZ_SMALL, OFF_S5W2 = OFF_S5W1 + 2 * SZ_S5W1, OFF_KD = OFF_S5W2 + 2 * SZ_S5W2;
constexpr size_t SZ_MODS = 2 * 5 * 6144 * 4;
constexpr size_t OFF_MODS = OFF_KD + 2 * SZ_KD;
constexpr size_t OFF_XCTX = OFF_MODS + SZ_MODS, SZ_XCTX = (size_t)NB * LCTX * DM * 4;
constexpr size_t OFF_AY = OFF_XCTX + SZ_XCTX, SZ_AY = (size_t)NTOK * DM * 2;
constexpr size_t OFF_BIG = OFF_AY + SZ_AY, SZ_H = (size_t)NTOK * DFF * 2, SZ_P = (size_t)NTOK * PP * 2;
constexpr size_t OFF_RI = OFF_BIG + SZ_P;
constexpr size_t WS_NEED = 268435456;
constexpr size_t SZ_RI = WS_NEED - OFF_RI;
static_assert(OFF_BIG + SZ_H <= WS_NEED, "H does not fit");
constexpr size_t OFF_W12 = OFF_W1, SZ_W12 = SZ_W1 + SZ_W2;
constexpr size_t SZ_GQK = (size_t)NTOK * 768 * 2, SZ_HEND = (size_t)NB * NCH16 * 16 * 256 * 2;
constexpr size_t OFF_GQK = OFF_AY, OFF_HEND = OFF_AY + SZ_GQK;
static_assert(SZ_GQK + SZ_HEND <= SZ_AY, "AY scratch");
constexpr size_t SZ_GV = (size_t)NTOK * 384 * 2, SZ_BG = (size_t)NTOK * 24 * 4;
constexpr size_t OFF_GV = OFF_W12, OFF_BG = OFF_GV + SZ_GV;
static_assert(SZ_GV + SZ_BG <= SZ_W12, "W12 scratch");
constexpr size_t SZ_RL1 = (size_t)NTOK * 1152 * 2, SZ_RL3 = (size_t)NTOK * 128 * 2, SZ_INVN = (size_t)NTOK * 6 * 4, SZ_WB = (size_t)NTOK * 384 * 2, SZ_YB2 = (size_t)NTOK * 128 * 2;
constexpr size_t OFF_RL1 = OFF_RI, OFF_RL3 = OFF_RL1 + SZ_RL1, OFF_INVN = OFF_RL3 + SZ_RL3, OFF_WB = OFF_INVN + SZ_INVN;
constexpr size_t OFF_YB2 = OFF_WB + SZ_WB;
static_assert(OFF_YB2 + SZ_YB2 <= WS_NEED - 16384, "RI scratch");
constexpr size_t RI_PART = 0, SZ_PART = 16 * SZ_MODS;
static_assert(SZ_PART <= SZ_RI, "part");
constexpr int PC_RL2 = 1792;

struct Params { const float* in[38]; float* out; unsigned char* ws; };
enum { I_X = 0, I_C, I_CTX, I_CCTX, I_MODW, I_MODB, I_NMIX, I_NMLP, I_NFIN, I_WIN, I_WOUT, I_BRE, I_BIM, I_CRE, I_CIM, I_S5D, I_ARE, I_AIM, I_LDT, I_GLUW, I_GLUB,
       I_GCONV, I_GALOG, I_GDTB, I_GNORM, I_MU, I_W0, I_WUP, I_A0, I_AUP, I_GUP, I_KK, I_KA, I_RK, I_LNW, I_LNB, I_MW1, I_MW2 };

__device__ __forceinline__ int ltid(int wvs) { int t = (wvs << 6) | (int)__builtin_amdgcn_mbcnt_hi(~0u, __builtin_amdgcn_mbcnt_lo(~0u, 0u)); asm volatile("" : "+v"(t)); return t; }
__device__ __forceinline__ int lbid() { int b = __builtin_amdgcn_workgroup_id_x(); asm volatile("" : "+s"(b)); return b; }
__device__ __forceinline__ float row16_sum(float v);
__device__ __forceinline__ float wave_sum(float v) {
  v = row16_sum(v);
  const float a = __builtin_bit_cast(float, __builtin_amdgcn_readlane(__builtin_bit_cast(int, v), 0)), b = __builtin_bit_cast(float, __builtin_amdgcn_readlane(__builtin_bit_cast(int, v), 16));
  const float c = __builtin_bit_cast(float, __builtin_amdgcn_readlane(__builtin_bit_cast(int, v), 32)), d = __builtin_bit_cast(float, __builtin_amdgcn_readlane(__builtin_bit_cast(int, v), 48));
  return (a + b) + (c + d);
}
__device__ __forceinline__ float row16_sum(float v) {
  v += __builtin_bit_cast(float, __builtin_amdgcn_update_dpp(0, __builtin_bit_cast(int, v), 0xB1, 0xF, 0xF, true));
  v += __builtin_bit_cast(float, __builtin_amdgcn_update_dpp(0, __builtin_bit_cast(int, v), 0x4E, 0xF, 0xF, true));
  v += __builtin_bit_cast(float, __builtin_amdgcn_update_dpp(0, __builtin_bit_cast(int, v), 0x141, 0xF, 0xF, true));
  v += __builtin_bit_cast(float, __builtin_amdgcn_update_dpp(0, __builtin_bit_cast(int, v), 0x140, 0xF, 0xF, true));
  return v;
}
__device__ __forceinline__ float sigmoidf_(float x) { return __builtin_amdgcn_rcpf(1.0f + __expf(-x)); }
__device__ __forceinline__ float siluf_(float x) { return x * __builtin_amdgcn_rcpf(1.0f + __expf(-x)); }
__device__ __forceinline__ float softplusf_(float x) { return x > 20.f ? x : __logf(1.0f + __expf(x)); }
__device__ __forceinline__ float tanhf_(float x) { const float e = __expf(2.0f * fminf(fmaxf(x, -15.f), 15.f)); return (e - 1.0f) * __builtin_amdgcn_rcpf(e + 1.0f); }
__device__ __forceinline__ float gelu_tanh(float x) { const float u = 0.7978845608028654f * (x + 0.044715f * x * x * x); return 0.5f * x * (1.0f + tanhf_(u)); }
__device__ __forceinline__ f32x4 mfma16(h8 a, h8 b, f32x4 c) { return __builtin_amdgcn_mfma_f32_16x16x32_f16(a, b, c, 0, 0, 0); }
__device__ __forceinline__ size_t xrow_off(int tok, bool& isctx) { const int b = tok / TPB, pos = tok - b * TPB; isctx = pos < LCTX; return isctx ? (size_t)(b * LCTX + pos) * DM : (size_t)(b * 4096 + pos - LCTX) * DM; }
__device__ __forceinline__ int mod_index(int tok) { const int b = tok / TPB, pos = tok - b * TPB; return pos < LCTX ? 4 : b; }

__device__ __forceinline__ Params load_params() {
#if defined(__HIP_DEVICE_COMPILE__)
  const __attribute__((address_space(4))) Params* kp = (const __attribute__((address_space(4))) Params*)__builtin_amdgcn_kernarg_segment_ptr(); asm volatile("" : "+s"(kp)); return *kp;
#else
  return Params{};
#endif
}

#define XB_TMO      128
#define XB_XCNT(j)  (256  + 64 * (j))
#define XB_XSUB(j)  (1280 + 64 * (j))
#define XB_XGEN(j)  (2304 + 64 * (j))
#define XB_TOP      3328
#define XB_TOPGEN   3392
#define XCD_BAR_WORDS 3456
#define XB_SPIN_CAP (1u << 22)
constexpr size_t OFF_BAR = WS_NEED - 16384;
constexpr int LDS_ST_OFF = 156 * 1024 - 16;
__device__ __forceinline__ unsigned xb_ld(unsigned* p)              { return __hip_atomic_load(p, __ATOMIC_RELAXED, __HIP_MEMORY_SCOPE_AGENT); }
__device__ __forceinline__ unsigned xb_add(unsigned* p, unsigned v) { return __hip_atomic_fetch_add(p, v, __ATOMIC_RELAXED, __HIP_MEMORY_SCOPE_AGENT); }
__device__ __forceinline__ unsigned xb_xcc_id() { return (unsigned)__builtin_amdgcn_s_getreg((3 << 11) | 20) & 0xFu; }
#define XB_SPIN(cond, bar) do { unsigned _sp = 0; while (cond) { __builtin_amdgcn_s_sleep(1); \
    if ((++_sp & 255u) == 0u) { if (xb_ld(&(bar)[XB_TMO])) break; if (_sp > XB_SPIN_CAP) { atomicAdd(&(bar)[XB_TMO], 1u); break; } } } } while (0)
__device__ __forceinline__ void xcd_post(const int wvs) {
  const Params p = load_params(); unsigned* bar = (unsigned*)(p.ws + OFF_BAR);
  if (ltid(wvs) == 0) (void)xb_add(&bar[XB_XCNT(xb_xcc_id())], 1u);
}
__device__ __forceinline__ void xcd_complete(unsigned* bar, unsigned x, unsigned& nloc, unsigned& nx) {
  const unsigned G = NWG; unsigned sum, cnt, mine, sp = 0u;
  for (;;) { sum = 0u; cnt = 0u; mine = 0u;
#pragma unroll
    for (unsigned j = 0; j < 16; ++j) { const unsigned c = xb_ld(&bar[XB_XCNT(j)]); sum += c; cnt += (c > 0u) ? 1u : 0u; mine = (j == x) ? c : mine; }
    if (sum == G) break;
    __builtin_amdgcn_s_sleep(1);
    if ((++sp & 255u) == 0u) { if (xb_ld(&bar[XB_TMO])) break; if (sp > XB_SPIN_CAP) { atomicAdd(&bar[XB_TMO], 1u); break; } } }
  nloc = mine > 0u ? mine : 1u; nx = cnt > 0u ? cnt : 1u;
}
__device__ __forceinline__ void gsync(const int wvs, LAS unsigned char* lds) {
  asm volatile("s_waitcnt vmcnt(0)" ::: "memory");
  __syncthreads();
  if (ltid(wvs) == 0) {
    const Params p = load_params(); unsigned* bar = (unsigned*)(p.ws + OFF_BAR); volatile LAS unsigned* st = (volatile LAS unsigned*)(lds + LDS_ST_OFF); const unsigned x = xb_xcc_id();
    __builtin_amdgcn_s_waitcnt(0);
    unsigned nloc = st[0], nx = st[1];
    if (nloc == 0u) { xcd_complete(bar, x, nloc, nx); st[0] = nloc; st[1] = nx; }
    const unsigned old = xb_add(&bar[XB_XSUB(x)], 1u);
    const unsigned gen = old / nloc;
    if (old + 1u == (gen + 1u) * nloc) {
      __builtin_amdgcn_fence(__ATOMIC_RELEASE, "agent");
      asm volatile("s_waitcnt vmcnt(0)" ::: "memory");
      const unsigned og = xb_add(&bar[XB_TOP], 1u);
      const unsigned tg = og / nx;
      if (og + 1u == (tg + 1u) * nx) xb_add(&bar[XB_TOPGEN], 1u);
      else XB_SPIN(xb_ld(&bar[XB_TOPGEN]) == tg, bar);
      __builtin_amdgcn_fence(__ATOMIC_ACQUIRE, "agent");
      xb_add(&bar[XB_XGEN(x)], 1u);
      asm volatile("s_waitcnt vmcnt(0)" ::: "memory");
    } else {
      XB_SPIN(xb_ld(&bar[XB_XGEN(x)]) == gen, bar);
      __builtin_amdgcn_fence(__ATOMIC_ACQUIRE, "agent");
      asm volatile("s_waitcnt vmcnt(0)" ::: "memory");
    }
  }
  __syncthreads();
}

namespace pg8 {
constexpr int BM = 256, BK = 64, HALF = 128, HTB = HALF * BK * 2, STAGE_BYTES = 8 * HTB, NXCD = 8, WGM = 8;
__host__ __device__ __forceinline__ int lds_byte(int r, int c) { const int st = (r >> 4) * 2 + (c >> 5), rr = r & 15, cc = c & 31, ob = rr * 64 + cc * 2; return st * 1024 + (ob ^ (((ob >> 9) & 1) << 5)); }
__host__ __device__ __forceinline__ void stage_rc(int b, int& R, int& C) { const int st = b / 1024, sb = b % 1024, swz = sb ^ (((sb >> 9) & 1) << 5); R = (st >> 1) * 16 + swz / 64; C = (st & 1) * 32 + (swz % 64) / 2; }
__host__ __device__ __forceinline__ int perm32(int rho) { const int n = rho >> 4, i = rho & 15; return 8 * (i >> 2) + 4 * n + (i & 3); }
struct Unit { int pm, pn, kofs; };
struct Gemm { const hf* A; const hf* Bt; int M, N, K, ld; };
struct StaticOrder {
    int nM, nN, nwg, G, c; bool latonly; int nsplit, kpart;
    __device__ void init(int M, int N, int G_, int c_, bool lo = false) { latonly = lo; nsplit = 0; kpart = 0; nM = lo ? 64 : M / BM; nN = N / BM; nwg = nM * nN; G = G_; c = c_; }
    __device__ void init_ctxsplit(int N, int G_, int c_, int nsplit_, int kpart_) { latonly = false; nsplit = nsplit_; kpart = kpart_; nM = 4; nN = N / BM; nwg = 4 * nN * nsplit_; G = G_; c = c_; }
    __device__ bool next(int i, Unit& u) const {
        const long L = (long)i * G + c; if (L >= nwg) return false;
        u.kofs = 0;
        if (nsplit > 0) { const int kp = (int)L % nsplit, cu = (int)L / nsplit; u.pm = (cu / nN) * 17; u.pn = cu % nN; u.kofs = kp * kpart; return true; }
        int wgid = (int)L; { const int q = nwg / NXCD, r = nwg % NXCD, xcd = wgid % NXCD, off = wgid / NXCD; wgid = (xcd < r ? xcd * (q + 1) : r * (q + 1) + (xcd - r) * q) + off; }
        const int nig = WGM * nN, gid = wgid / nig, fm = gid * WGM, gsz = (nM - fm) < WGM ? (nM - fm) : WGM;
        u.pm = fm + ((wgid % nig) % gsz); u.pn = (wgid % nig) / gsz; if (latonly) u.pm = (u.pm >> 4) * 17 + 1 + (u.pm & 15); return true;
    }
};
template <class Epi>
__device__ __forceinline__ void gemm_phase(const int wvs, LAS unsigned char* lds, const Gemm g, const StaticOrder& S, const Epi& E) {
    const int tid = ltid(wvs), wid = __builtin_amdgcn_readfirstlane(tid >> 6), lane = tid & 63, wr = wid >> 2, wc = wid & 3, fr = lane & 15, fq = lane >> 4;
    const int K = g.ld, nt = g.K / BK;
    unsigned voffA[2], voffB[2];
#pragma unroll
    for (int i = 0; i < 2; ++i) { int R, C; stage_rc(tid * 16 + i * 8192, R, C); const int Rb = Epi::PERM ? ((R & ~31) + perm32(R & 31)) : R;
        voffA[i] = (unsigned)(R * K + C) * 2u; voffB[i] = (unsigned)(Rb * K + C) * 2u; }
    const size_t kstep = (size_t)(BK * 2);
    const size_t hstep = (size_t)HALF * K * 2;
    const size_t tstep = 2 * hstep;
    const unsigned ldsw = (unsigned)wid * 1024u;
    const int aoff = lds_byte(wr * 64 + fr, fq * 8), boff = lds_byte(wc * 32 + fr, fq * 8);
#define PG8_SA(b, h) (((b) * 2 + (h)) * HTB)
#define PG8_SB(b, h) ((4 + (b) * 2 + (h)) * HTB)
#define PG8_STAGE(bufoff, gbase, voff) do { _Pragma("unroll") for (int _i = 0; _i < 2; ++_i) \
        __builtin_amdgcn_global_load_lds((const unsigned*)((const char*)(gbase) + (voff)[_i]), (LAS unsigned*)(lds + (bufoff) + ldsw + _i * 8192), 16, 0, 0); } while (0)
#define PG8_LDA(dst, b, h) do { _Pragma("unroll") for (int m = 0; m < 4; ++m) _Pragma("unroll") for (int k = 0; k < 2; ++k) dst[m][k] = *(const LAS h8*)(lds + PG8_SA(b, h) + aoff + m * 2048 + k * 1024); } while (0)
#define PG8_LDB(dst, b, h) do { _Pragma("unroll") for (int n = 0; n < 2; ++n) _Pragma("unroll") for (int k = 0; k < 2; ++k) dst[n][k] = *(const LAS h8*)(lds + PG8_SB(b, h) + boff + n * 2048 + k * 1024); } while (0)
#define PG8_MMA(ai, bj, At, Bt) do { __builtin_amdgcn_s_setprio(1); _Pragma("unroll") for (int m = 0; m < 4; ++m) _Pragma("unroll") for (int n = 0; n < 2; ++n) _Pragma("unroll") for (int k = 0; k < 2; ++k) \
        acc[ai][bj][m][n] = __builtin_amdgcn_mfma_f32_16x16x32_f16(Bt[n][k], At[m][k], acc[ai][bj][m][n], 0, 0, 0); __builtin_amdgcn_s_setprio(0); } while (0)
#define PG8_WAIT_V(n) asm volatile("s_waitcnt vmcnt(" #n ")" ::: "memory")
#define PG8_WAIT_L(n) asm volatile("s_waitcnt lgkmcnt(" #n ")" ::: "memory")
#define PG8_BAR __builtin_amdgcn_s_barrier()
#define PG8_SCHED __builtin_amdgcn_sched_barrier(0)
    Unit cur, nxt; int ui = 0;
    if (!S.next(0, cur)) return;
    f32x4 acc[2][2][4][2];
#pragma unroll
    for (int a = 0; a < 2; ++a)
#pragma unroll
        for (int b = 0; b < 2; ++b)
#pragma unroll
            for (int m = 0; m < 4; ++m)
#pragma unroll
                for (int n = 0; n < 2; ++n) acc[a][b][m][n] = (f32x4){0.f, 0.f, 0.f, 0.f};
    h8 At[4][2], B0[2][2], B1[2][2];
    const char* cA = (const char*)g.A + (size_t)cur.pm * tstep + (size_t)cur.kofs * 2; const char* cB = (const char*)g.Bt + (size_t)cur.pn * tstep + (size_t)cur.kofs * 2;
    PG8_STAGE(PG8_SB(0, 0), cB, voffB); PG8_STAGE(PG8_SA(0, 0), cA, voffA); PG8_STAGE(PG8_SB(0, 1), cB + hstep, voffB); PG8_STAGE(PG8_SA(0, 1), cA + hstep, voffA);
    if (wr == 1) PG8_BAR;
    PG8_WAIT_V(4); PG8_BAR;
    PG8_STAGE(PG8_SB(1, 0), cB + kstep, voffB); PG8_STAGE(PG8_SA(1, 0), cA + kstep, voffA); PG8_STAGE(PG8_SB(1, 1), cB + hstep + kstep, voffB);
    PG8_WAIT_V(6); PG8_BAR;
    for (;;) {
        const bool has_next = S.next(ui + 1, nxt);
        const char* nA = has_next ? (const char*)g.A + (size_t)nxt.pm * tstep + (size_t)nxt.kofs * 2 : cA; const char* nB = has_next ? (const char*)g.Bt + (size_t)nxt.pn * tstep + (size_t)nxt.kofs * 2 : cB;
        for (int t = 0; t < nt; t += 2) {
            const bool last = (t == nt - 2);
            const char* a1 = cA + (size_t)(t + 1) * kstep;
            const char* a2 = last ? nA : cA + (size_t)(t + 2) * kstep; const char* b2 = last ? nB : cB + (size_t)(t + 2) * kstep;
            const char* a3 = a2 + kstep; const char* b3 = b2 + kstep;
            PG8_LDB(B0, 0, 0); PG8_SCHED; PG8_LDA(At, 0, 0); PG8_STAGE(PG8_SA(1, 1), a1 + hstep, voffA);
            PG8_WAIT_L(8); PG8_BAR; PG8_WAIT_L(0); PG8_MMA(0, 0, At, B0); PG8_BAR; PG8_SCHED;
            PG8_LDB(B1, 0, 1); PG8_STAGE(PG8_SB(0, 0), b2, voffB);
            PG8_BAR; PG8_WAIT_L(0); PG8_MMA(0, 1, At, B1); PG8_BAR;
            PG8_LDA(At, 0, 1); PG8_STAGE(PG8_SA(0, 0), a2, voffA);
            PG8_BAR; PG8_WAIT_L(0); PG8_MMA(1, 0, At, B0); PG8_BAR; PG8_SCHED;
            PG8_STAGE(PG8_SB(0, 1), b2 + hstep, voffB);
            PG8_WAIT_V(6); PG8_BAR; PG8_MMA(1, 1, At, B1); PG8_BAR;
            PG8_LDB(B0, 1, 0); PG8_SCHED; PG8_LDA(At, 1, 0); PG8_STAGE(PG8_SA(0, 1), a2 + hstep, voffA);
            PG8_WAIT_L(8); PG8_BAR; PG8_WAIT_L(0); PG8_MMA(0, 0, At, B0); PG8_BAR; PG8_SCHED;
            PG8_LDB(B1, 1, 1); PG8_STAGE(PG8_SB(1, 0), b3, voffB);
            PG8_BAR; PG8_WAIT_L(0); PG8_MMA(0, 1, At, B1); PG8_BAR;
            PG8_LDA(At, 1, 1); PG8_STAGE(PG8_SA(1, 0), a3, voffA);
            PG8_BAR; PG8_WAIT_L(0); PG8_MMA(1, 0, At, B0); PG8_BAR; PG8_SCHED;
            PG8_STAGE(PG8_SB(1, 1), b3 + hstep, voffB);
            PG8_WAIT_V(6); PG8_BAR; PG8_MMA(1, 1, At, B1); PG8_BAR;
        }
        E(acc, cur, wr, wc, fr, fq);
        if (!has_next) break;
#pragma unroll
        for (int a = 0; a < 2; ++a)
#pragma unroll
            for (int b = 0; b < 2; ++b)
#pragma unroll
                for (int m = 0; m < 4; ++m)
#pragma unroll
                    for (int n = 0; n < 2; ++n) acc[a][b][m][n] = (f32x4){0.f, 0.f, 0.f, 0.f};
        cur = nxt; cA = nA; cB = nB; ++ui;
    }
    PG8_WAIT_V(0);
    if (wr == 0) PG8_BAR;
    PG8_BAR;
#undef PG8_SA
#undef PG8_SB
#undef PG8_STAGE
#undef PG8_LDA
#undef PG8_LDB
#undef PG8_MMA
#undef PG8_WAIT_V
#undef PG8_WAIT_L
#undef PG8_BAR
#undef PG8_SCHED
}
template <int ACT  > struct EpiF16 {
    static constexpr bool PERM = true;
    __device__ __forceinline__ void operator()(const f32x4 (&acc)[2][2][4][2], const Unit& u, int wr, int wc, int fr, int fq) const {
        const Params p = load_params(); hf* O = (hf*)(p.ws + OFF_BIG); constexpr int ldc = ACT == 0 ? PP : DFF;
        asm volatile("" : "+v"(fr), "+v"(fq));
        const int row0 = u.pm * BM + wr * 64 + fr, col0 = u.pn * BM + wc * 32 + 8 * fq;
#pragma unroll
        for (int ai = 0; ai < 2; ++ai)
#pragma unroll
            for (int m = 0; m < 4; ++m) { hf* rowp = O + (size_t)(row0 + ai * HALF + m * 16) * ldc + col0;
#pragma unroll
                for (int bj = 0; bj < 2; ++bj) { f32x4 v0 = acc[ai][bj][m][0], v1 = acc[ai][bj][m][1];
                    if (ACT == 1) {
#pragma unroll
                        for (int j = 0; j < 4; ++j) { const float a = fmaxf(v0[j], 0.f), b = fmaxf(v1[j], 0.f); v0[j] = a * a; v1[j] = b * b; } }
                    h8 w; w[0] = (hf)v0[0]; w[1] = (hf)v0[1]; w[2] = (hf)v0[2]; w[3] = (hf)v0[3]; w[4] = (hf)v1[0]; w[5] = (hf)v1[1]; w[6] = (hf)v1[2]; w[7] = (hf)v1[3];
                    *(h8*)(rowp + bj * HALF) = w; } }
    }
};
struct EpiPart {
    static constexpr bool PERM = false;
    size_t part_off; int kpart;
    __device__ __forceinline__ void operator()(const f32x4 (&acc)[2][2][4][2], const Unit& u, int wr, int wc, int fr, int fq) const {
        const Params p = load_params(); asm volatile("" : "+v"(fr), "+v"(fq));
        float* part = (float*)(p.ws + part_off) + (size_t)(u.kofs / kpart) * (NB * LCTX * DM) + (size_t)((u.pm / 17) * LCTX) * DM;
        const int col0 = u.pn * BM + wc * 32 + 4 * fq, rloc = wr * 64 + fr;
#pragma unroll
        for (int ai = 0; ai < 2; ++ai)
#pragma unroll
            for (int m = 0; m < 4; ++m)
#pragma unroll
                for (int bj = 0; bj < 2; ++bj)
#pragma unroll
                    for (int n = 0; n < 2; ++n) *(f32x4*)(part + (size_t)(rloc + ai * HALF + m * 16) * DM + col0 + bj * HALF + n * 16) = acc[ai][bj][m][n];
    }
};
struct EpiRes {
    static constexpr bool PERM = false;
    int layer, which; bool atomic;
    __device__ __forceinline__ void operator()(const f32x4 (&acc)[2][2][4][2], const Unit& u, int wr, int wc, int fr, int fq) const {
        const Params p = load_params(); float* ctx_out = (float*)(p.ws + OFF_XCTX); float* lat_out = p.out;
        asm volatile("" : "+v"(fr), "+v"(fq));
        const bool first = (layer == 0 && which == 0); const float* lat_in = first ? p.in[I_X] : (const float*)p.out; const float* ctx_in = first ? p.in[I_CTX] : (const float*)ctx_out;
        const float* gate = (const float*)(p.ws + OFF_MODS) + (size_t)layer * 5 * 6144 + (which == 0 ? 2 : 5) * DM;
        const int b = u.pm / 17, w = u.pm - b * 17; const bool isctx = (w == 0);
        const size_t rbase = isctx ? (size_t)(b * LCTX) * DM : (size_t)(b * 4096 + (w - 1) * 256) * DM;
        const float* xin = (isctx ? ctx_in : lat_in) + rbase; float* xout = (isctx ? ctx_out : lat_out) + rbase;
        const float* gp = gate + (size_t)(isctx ? 4 : b) * 6144;
        const int col0 = u.pn * BM + wc * 32 + 4 * fq, rloc = wr * 64 + fr;
#pragma unroll
        for (int bj = 0; bj < 2; ++bj)
#pragma unroll
            for (int n = 0; n < 2; ++n) { const f32x4 gv = *(const f32x4*)(gp + col0 + bj * HALF + n * 16);
#pragma unroll
                for (int ai = 0; ai < 2; ++ai)
#pragma unroll
                    for (int m = 0; m < 4; ++m) { const size_t ro = (size_t)(rloc + ai * HALF + m * 16) * DM + col0 + bj * HALF + n * 16;
                        if (atomic) { const f32x4 v = gv * acc[ai][bj][m][n];
#pragma unroll
                            for (int j = 0; j < 4; ++j) unsafeAtomicAdd(xout + ro + j, v[j]); }
                        else { const f32x4 xi = *(const f32x4*)(xin + ro); *(f32x4*)(xout + ro) = xi + gv * acc[ai][bj][m][n]; } }
                asm volatile("" ::: "memory"); }
    }
};
}

__device__ __forceinline__ int win_srccol(int n) { if (n < 256) return n; if (n < 2048) { const int j = n - 256; return j < 1560 ? 256 + j : -1; } return 1816 + (n - 2048); }
__device__ __forceinline__ void convert_weight(const int wvs, LAS unsigned char* lds, const float* src, hf* dst, int K, int Nsrc, int Ndst, bool wmap, int t0, int& tbase) {
  LAS float* tl = (LAS float*)lds;
  const int nkt = K / 64, nnt = Ndst / 64, ntiles = nkt * nnt, tid = ltid(wvs), ty = tid >> 6, tx = tid & 63;
  int t = t0; while (t < tbase) t += NWG;
  for (; t < tbase + ntiles; t += 4 * NWG) {
    float v[4][8];
#pragma unroll
    for (int u = 0; u < 4; ++u) { const int tu = t + u * NWG; const bool ok = tu < tbase + ntiles; const int tt = ok ? tu - tbase : 0, kt = tt % nkt, ntl = tt / nkt, k0 = kt * 64, n0 = ntl * 64;
      const int n = n0 + tx, sc = wmap ? win_srccol(n) : n;
#pragma unroll
      for (int r = 0; r < 8; ++r) { const int k = k0 + ty + 8 * r; v[u][r] = (ok && sc >= 0) ? src[(size_t)k * Nsrc + sc] : 0.f; } }
#pragma unroll
    for (int u = 0; u < 4; ++u)
#pragma unroll
      for (int r = 0; r < 8; ++r) tl[u * 4160 + (ty + 8 * r) * 65 + tx] = v[u][r];
    __syncthreads();
#pragma unroll
    for (int u = 0; u < 4; ++u) { const int tu = t + u * NWG; if (tu < tbase + ntiles) { const int tt = tu - tbase, kt = tt % nkt, ntl = tt / nkt, k0 = kt * 64, n0 = ntl * 64;
#pragma unroll
        for (int r = 0; r < 8; ++r) { const int nn = n0 + ty + 8 * r; dst[(size_t)nn * K + k0 + tx] = (hf)tl[u * 4160 + tx * 65 + ty + 8 * r]; } } }
    __syncthreads();
  }
  tbase += ntiles;
}
__device__ __forceinline__ void phase_convert(const int wvs, const Params& p, LAS unsigned char* lds, int layer, int which  ) {
  int tbase = 0; const int b = lbid();
  if (which == 0) {
    convert_weight(wvs, lds, p.in[I_WIN] + (size_t)layer * DM * 3352, (hf*)(p.ws + OFF_WIN), DM, 3352, PP, true, b, tbase);
    int t0 = b; while (t0 < tbase) t0 += NWG;
    convert_weight(wvs, lds, p.in[I_WOUT] + (size_t)layer * DM * DM, (hf*)(p.ws + OFF_WOUT), DM, DM, DM, false, t0, tbase);
  } else {
    convert_weight(wvs, lds, p.in[I_MW1] + (size_t)layer * DM * DFF, (hf*)(p.ws + OFF_W1), DM, DFF, DFF, false, b, tbase);
    int t0 = b; while (t0 < tbase) t0 += NWG;
    convert_weight(wvs, lds, p.in[I_MW2] + (size_t)layer * DFF * DM, (hf*)(p.ws + OFF_W2), DFF, DM, DM, false, t0, tbase);
  }
}

__device__ __forceinline__ void phase0a(const int wvs, const Params& p, LAS unsigned char* lds) {
  const int tid = ltid(wvs);
  { LAS float* sl = (LAS float*)lds;
    float* part = (float*)(p.ws + OFF_RI + RI_PART);
    for (int it = lbid(); it < 2 * 12 * 16; it += NWG) {
      const int ks = it % 16, jc = (it / 16) % 12, l = it / 192;
      __syncthreads();
      if (tid < 320) { const int mi = tid / 64, k = ks * 64 + (tid & 63); const float cv = mi < 4 ? p.in[I_C][mi * DM + k] : p.in[I_CCTX][k]; sl[tid] = siluf_(cv); }
      __syncthreads();
      const int j = jc * 512 + tid; float a0 = 0, a1 = 0, a2 = 0, a3 = 0, a4 = 0;
      const float* wp = p.in[I_MODW] + ((size_t)l * DM + ks * 64) * 6144 + j;
#pragma unroll 8
      for (int k = 0; k < 64; ++k) { const float w = wp[(size_t)k * 6144]; a0 += sl[k] * w; a1 += sl[64 + k] * w; a2 += sl[128 + k] * w; a3 += sl[192 + k] * w; a4 += sl[256 + k] * w; }
      float* o = part + ((size_t)(l * 16 + ks) * 5) * 6144 + j; o[0] = a0; o[6144] = a1; o[2 * 6144] = a2; o[3 * 6144] = a3; o[4 * 6144] = a4;
    }
    __syncthreads();
  }
  { LAS float* T = (LAS float*)lds;
    float* kd = (float*)(p.ws + OFF_KD);
    for (int it = lbid(); it < 2 * 2 * 16 * 16; it += NWG) {
      const int delta = it % 16, g = (it / 16) % 16, d = (it / 256) % 2, l = it / 512;
      __syncthreads();
      if (tid < 64) { const int pi = ((l * 2 + d) * 16 + g) * 64 + tid; const float ar = p.in[I_ARE][pi], ai = p.in[I_AIM][pi], dt = expf(p.in[I_LDT][(l * 2 + d) * 16 + g]);
        float s1, c1; sincosf(dt * ai, &s1, &c1); const float m1 = expf(dt * ar); const float lr = m1 * c1 - 1.f, li = m1 * s1; const float den = 1.f / (ar * ar + ai * ai);
        const float cr = (lr * ar + li * ai) * den, ci = (li * ar - lr * ai) * den;
        float sd, cd; sincosf((float)delta * dt * ai, &sd, &cd); const float md = expf((float)delta * dt * ar); const float pr = md * cd, pim = md * sd;
        T[tid * 2] = cr * pr - ci * pim; T[tid * 2 + 1] = cr * pim + ci * pr; }
      __syncthreads();
      if (tid < 256) { const int c = tid >> 4, cp = tid & 15; float s = 0.f;
        const float* cre = p.in[I_CRE] + ((size_t)(l * 16 + g) * 16 + c) * 64; const float* cim = p.in[I_CIM] + ((size_t)(l * 16 + g) * 16 + c) * 64;
        const float* bre = p.in[I_BRE] + ((size_t)(l * 16 + g) * 64) * 16 + cp; const float* bim = p.in[I_BIM] + ((size_t)(l * 16 + g) * 64) * 16 + cp;
        for (int q = 0; q < 64; ++q) { const float tr = T[q * 2], ti = T[q * 2 + 1], xr = cre[q], xi = cim[q], yr = bre[q * 16], yi = bim[q * 16];
          const float ur = xr * tr - xi * ti, ui = xr * ti + xi * tr; s += ur * yr - ui * yi; }
        kd[(((size_t)(l * 2 + d) * 16 + g) * 16 + delta) * 256 + tid] = s; }
    }
    __syncthreads();
  }
  { const int gt = lbid() * 512 + tid, gs = NWG * 512;
    for (int l = 0; l < 2; ++l) { unsigned char* sb = p.ws + OFF_SMALL + (size_t)l * SZ_SMALL;
      hf* gluT = (hf*)sb; hf* wupT = (hf*)(sb + SZ_GLUT); hf* aupT = (hf*)(sb + SZ_GLUT + SZ_WUPT); hf* gupT = (hf*)(sb + SZ_GLUT + 2 * SZ_WUPT);
      for (int i = gt; i < 65536; i += gs) { const int n = i >> 8, k = i & 255; gluT[i] = (hf)p.in[I_GLUW][(size_t)l * 65536 + k * 256 + n]; }
      for (int i = gt; i < 2 * 384 * 64; i += gs) { const int r = i & 63, n = (i >> 6) % 384, d = i / (384 * 64); const size_t si = ((size_t)(l * 2 + d) * 64 + r) * 384 + n;
        wupT[i] = (hf)p.in[I_WUP][si]; aupT[i] = (hf)p.in[I_AUP][si]; }
      for (int i = gt; i < 384 * 128; i += gs) { const int r = i & 127, n = i >> 7; gupT[i] = (hf)p.in[I_GUP][((size_t)l * 128 + r) * 384 + n]; }
    }
  }
}

__device__ __forceinline__ void phase0b(const int wvs, const Params& p) {
  const int tid = ltid(wvs), gt = lbid() * 512 + tid, gs = NWG * 512;
  { const float* part = (const float*)(p.ws + OFF_RI + RI_PART); float* mods = (float*)(p.ws + OFF_MODS);
    for (int i = gt; i < 2 * 5 * 6144; i += gs) { const int j = i % 6144, mi = (i / 6144) % 5, l = i / 30720; float s = p.in[I_MODB][l * 6144 + j];
      for (int ks = 0; ks < 16; ++ks) s += part[((size_t)(l * 16 + ks) * 5 + mi) * 6144 + j];
      mods[i] = s; } }
  for (int i = gt; i < 2 * 16 * 2 * 64 * 16; i += gs) {
    const int s = i & 15, q = (i >> 4) & 63, d = (i >> 10) & 1, g = (i >> 11) & 15, l = i >> 15;
    const int pi = ((l * 2 + d) * 16 + g) * 64 + q; const float ar = p.in[I_ARE][pi], ai = p.in[I_AIM][pi], dt = expf(p.in[I_LDT][(l * 2 + d) * 16 + g]);
    float s1, c1; sincosf(dt * ai, &s1, &c1); const float m1 = expf(dt * ar); const float lr = m1 * c1 - 1.f, li = m1 * s1; const float den = 1.f / (ar * ar + ai * ai);
    const float cr = (lr * ar + li * ai) * den, ci = (li * ar - lr * ai) * den;
    const float e = (float)(d == 0 ? 15 - s : s); float sd, cd; sincosf(e * dt * ai, &sd, &cd); const float md = expf(e * dt * ar);
    const float tr = cr * md * cd - ci * md * sd, ti = cr * md * sd + ci * md * cd;
    const float* bre = p.in[I_BRE] + ((size_t)(l * 16 + g) * 64 + q) * 16; const float* bim = p.in[I_BIM] + ((size_t)(l * 16 + g) * 64 + q) * 16;
    hf* w1 = (hf*)(p.ws + OFF_S5W1 + (size_t)l * SZ_S5W1) + ((size_t)(g * 256 + d * 128 + q * 2)) * 256 + s * 16;
    for (int c = 0; c < 16; ++c) { const float yr = bre[c], yi = bim[c]; w1[c] = (hf)(tr * yr - ti * yi); w1[256 + c] = (hf)(tr * yi + ti * yr); }
  }
  for (int i = gt; i < 2 * 16 * 2 * 64 * 16; i += gs) {
    const int j = i & 15, q = (i >> 4) & 63, d = (i >> 10) & 1, g = (i >> 11) & 15, l = i >> 15;
    const int pi = ((l * 2 + d) * 16 + g) * 64 + q; const float ar = p.in[I_ARE][pi], ai = p.in[I_AIM][pi], dt = expf(p.in[I_LDT][(l * 2 + d) * 16 + g]);
    const float e = (float)(d == 0 ? j + 1 : 16 - j); float sd, cd; sincosf(e * dt * ai, &sd, &cd); const float md = expf(e * dt * ar); const float tr = md * cd, ti = md * sd;
    hf* w2 = (hf*)(p.ws + OFF_S5W2 + (size_t)l * SZ_S5W2) + ((size_t)(g * 256 + j * 16)) * 512 + 256 + d * 128 + q * 2;
    for (int c = 0; c < 16; ++c) { const float xr = p.in[I_CRE][((size_t)(l * 16 + g) * 16 + c) * 64 + q], xi = p.in[I_CIM][((size_t)(l * 16 + g) * 16 + c) * 64 + q];
      w2[(size_t)c * 512] = (hf)(xr * tr - xi * ti); w2[(size_t)c * 512 + 1] = (hf)(-(xr * ti + xi * tr)); }
  }
}
__device__ __forceinline__ void phase0b_local(const int wvs, const Params& p) {
  const int gt = lbid() * 512 + ltid(wvs), gs = NWG * 512;
  const float* kd = (const float*)(p.ws + OFF_KD);
  for (int i = gt; i < 2 * 16 * 65536; i += gs) {
    const int k = i & 255, n = (i >> 8) & 255, g = (i >> 16) & 15, l = i >> 20; const int s = k >> 4, cp = k & 15, j = n >> 4, c = n & 15;
    float v = 0.f;
    if (s <= j) v += kd[(((size_t)(l * 2 + 0) * 16 + g) * 16 + (j - s)) * 256 + c * 16 + cp];
    if (s >= j) v += kd[(((size_t)(l * 2 + 1) * 16 + g) * 16 + (s - j)) * 256 + c * 16 + cp];
    if (s == j && c == cp) v += p.in[I_S5D][l * 256 + g * 16 + c];
    ((hf*)(p.ws + OFF_S5W2 + (size_t)l * SZ_S5W2))[((size_t)(g * 256 + n)) * 512 + k] = (hf)v;
  }
}

__device__ __forceinline__ void phase_prenorm(const int wvs, const Params& p, int layer, int which  , const float* lat, const float* ctx, bool fold) {
  const int lane = ltid(wvs) & 63, gw = lbid() * 8 + (ltid(wvs) >> 6);
  const float* gain = p.in[which == 0 ? I_NMIX : I_NMLP] + layer * DM; const float* mods = (const float*)(p.ws + OFF_MODS) + (size_t)layer * 5 * 6144;
  hf* A = (hf*)(p.ws + OFF_AY);
#pragma unroll 2
  for (int tok = gw; tok < NTOK; tok += NWAVES) {
    bool isctx; const size_t ro = xrow_off(tok, isctx); const float* xr = (isctx ? ctx : lat) + ro; const int mi = mod_index(tok);
    const float* sh = mods + (size_t)mi * 6144 + (which == 0 ? 0 : 3) * DM; const float* sc = sh + DM;
    f32x4 v[4]; float ss = 0.f;
#pragma unroll
    for (int i = 0; i < 4; ++i) v[i] = *(const f32x4*)(xr + lane * 4 + 256 * i);
    if (fold && isctx) {
      const float* gt = (const float*)(p.ws + OFF_MODS) + (size_t)4 * 6144 + (which == 1 ? 2 : 5) * DM;
      const float* part = (const float*)(p.ws + OFF_RI) + ro; float* xc = (float*)(p.ws + OFF_XCTX) + ro;
#pragma unroll
      for (int i = 0; i < 4; ++i) { const int k = lane * 4 + 256 * i; f32x4 s = *(const f32x4*)(part + k);
#pragma unroll
        for (int q = 1; q < 4; ++q) s += *(const f32x4*)(part + (size_t)q * (NB * LCTX * DM) + k);
        v[i] += *(const f32x4*)(gt + k) * s; *(f32x4*)(xc + k) = v[i]; } }
#pragma unroll
    for (int i = 0; i < 4; ++i) ss += v[i][0] * v[i][0] + v[i][1] * v[i][1] + v[i][2] * v[i][2] + v[i][3] * v[i][3];
    ss = wave_sum(ss); const float rs = rsqrtf(ss * (1.0f / DM) + 1e-6f);
#pragma unroll
    for (int i = 0; i < 4; ++i) { const int k = lane * 4 + 256 * i; const f32x4 g4 = *(const f32x4*)(gain + k), s4 = *(const f32x4*)(sc + k), h4v = *(const f32x4*)(sh + k); h4 o;
#pragma unroll
      for (int j = 0; j < 4; ++j) o[j] = (hf)((v[i][j] * rs * g4[j]) * (1.0f + s4[j]) + h4v[j]);
      *(h4*)(A + (size_t)tok * DM + k) = o; }
  }
}
__device__ __forceinline__ void phase_final(const int wvs, const Params& p) {
  const int lane = ltid(wvs) & 63, gw = lbid() * 8 + (ltid(wvs) >> 6); const float* gain = p.in[I_NFIN];
  for (int row = gw; row < NB * 4096; row += NWAVES) { float* xr = p.out + (size_t)row * DM; f32x4 v[4]; float ss = 0.f;
#pragma unroll
    for (int i = 0; i < 4; ++i) { v[i] = *(const f32x4*)(xr + lane * 4 + 256 * i); ss += v[i][0] * v[i][0] + v[i][1] * v[i][1] + v[i][2] * v[i][2] + v[i][3] * v[i][3]; }
    ss = wave_sum(ss); const float rs = rsqrtf(ss * (1.0f / DM) + 1e-6f);
#pragma unroll
    for (int i = 0; i < 4; ++i) { const int k = lane * 4 + 256 * i; const f32x4 g4 = *(const f32x4*)(gain + k); *(f32x4*)(xr + k) = v[i] * rs * g4; }
  }
}

__device__ __forceinline__ void s5a_task(const Params& p, int layer, int task, int lane) {
  const int fr = lane & 15, fq = lane >> 4;
  const hf* P = (const hf*)(p.ws + OFF_BIG); const hf* W1 = (const hf*)(p.ws + OFF_S5W1 + (size_t)layer * SZ_S5W1); hf* hend = (hf*)(p.ws + OFF_HEND);
  const int g = task & 15, cgi = task >> 4, cidx = cgi * 16 + fr, b = cidx / NCH16, n = cidx - b * NCH16; const size_t tokbase = (size_t)b * TPB + n * 16;
  f32x4 acc[16];
#pragma unroll
  for (int i = 0; i < 16; ++i) acc[i] = (f32x4){0.f, 0.f, 0.f, 0.f};
  h8 bfa[8];
#pragma unroll
  for (int ks = 0; ks < 8; ++ks) { const int s = ks * 2 + (fq >> 1), co = (fq & 1) * 8; bfa[ks] = *(const h8*)(P + (tokbase + s) * PP + PC_S5 + g * 16 + co); }
#pragma unroll 1
  for (int k2 = 0; k2 < 8; k2 += 2) { h8 a0[16], a1[16];
#pragma unroll
    for (int nt = 0; nt < 16; ++nt) { const hf* wp = W1 + ((size_t)(g * 256 + nt * 16 + fr)) * 256 + k2 * 32 + fq * 8; a0[nt] = *(const h8*)wp; a1[nt] = *(const h8*)(wp + 32); }
    const h8 b0 = (k2 == 0) ? bfa[0] : (k2 == 2) ? bfa[2] : (k2 == 4) ? bfa[4] : bfa[6], b1 = (k2 == 0) ? bfa[1] : (k2 == 2) ? bfa[3] : (k2 == 4) ? bfa[5] : bfa[7];
#pragma unroll
    for (int nt = 0; nt < 16; ++nt) { acc[nt] = mfma16(a0[nt], b0, acc[nt]); acc[nt] = mfma16(a1[nt], b1, acc[nt]); } }
#pragma unroll
  for (int nt = 0; nt < 16; ++nt) { h4 o; o[0] = (hf)acc[nt][0]; o[1] = (hf)acc[nt][1]; o[2] = (hf)acc[nt][2]; o[3] = (hf)acc[nt][3]; *(h4*)(hend + ((size_t)cidx * 16 + g) * 256 + nt * 16 + fq * 4) = o; }
}
__device__ __forceinline__ void phase_s5b(const int wvs, const Params& p, int layer, int wg0) {
  const int wgi = lbid() - wg0; if (wgi < 0 || wgi >= 16) return;
  const int gt = wgi * 512 + ltid(wvs);
  const int q = gt & 63, d = (gt >> 6) & 1, g = (gt >> 7) & 15, b = gt >> 11;
  const int pi = ((layer * 2 + d) * 16 + g) * 64 + q; const float ar = p.in[I_ARE][pi], ai = p.in[I_AIM][pi], dt = expf(p.in[I_LDT][(layer * 2 + d) * 16 + g]);
  float sd, cd; sincosf(16.f * dt * ai, &sd, &cd); const float md = expf(16.f * dt * ar); const float lr = md * cd, li = md * sd;
  hf* hend = (hf*)(p.ws + OFF_HEND);
  float hr = 0.f, hi = 0.f;
  h2 cur[16], nxt[16];
#define S5B_N(gi, j) (d == 0 ? (gi) * 16 + (j) : ((gi) == 0 ? 15 - (j) : (17 - (gi)) * 16 + 15 - (j)))
#define S5B_IX(n) (((size_t)(b * NCH16 + (n)) * 16 + g) * 256 + d * 128 + q * 2)
#pragma unroll
  for (int j = 0; j < 16; ++j) nxt[j] = *(const h2*)(hend + S5B_IX(S5B_N(0, j)));
#pragma unroll 1
  for (int gi = 0; gi < 17; ++gi) {
#pragma unroll
    for (int j = 0; j < 16; ++j) cur[j] = nxt[j];
    if (gi + 1 < 17) {
#pragma unroll
      for (int j = 0; j < 16; ++j) nxt[j] = *(const h2*)(hend + S5B_IX(S5B_N(gi + 1, j))); }
#pragma unroll
    for (int j = 0; j < 16; ++j) { h2 o; o[0] = (hf)hr; o[1] = (hf)hi; *(h2*)(hend + S5B_IX(S5B_N(gi, j))) = o;
      const float nr = lr * hr - li * hi + (float)cur[j][0], ni = lr * hi + li * hr + (float)cur[j][1]; hr = nr; hi = ni; }
  }
#undef S5B_N
#undef S5B_IX
}
__device__ __forceinline__ void s5c_task(const Params& p, int layer, int task, int lane) {
  const int fr = lane & 15, fq = lane >> 4;
  hf* P = (hf*)(p.ws + OFF_BIG); const hf* W2 = (const hf*)(p.ws + OFF_S5W2 + (size_t)layer * SZ_S5W2); const hf* hin = (const hf*)(p.ws + OFF_HEND);
  const int g = task & 15, cgi = task >> 4, cidx = cgi * 16 + fr, b = cidx / NCH16, n = cidx - b * NCH16; const size_t tokbase = (size_t)b * TPB + n * 16;
  f32x4 acc[16];
#pragma unroll
  for (int i = 0; i < 16; ++i) acc[i] = (f32x4){0.f, 0.f, 0.f, 0.f};
#pragma unroll 1
  for (int k2 = 0; k2 < 16; k2 += 2) { h8 a0[16], a1[16], b0, b1;
    if (k2 < 8) { const int s = k2 * 2 + (fq >> 1), co = (fq & 1) * 8; b0 = *(const h8*)(P + (tokbase + s) * PP + PC_S5 + g * 16 + co); b1 = *(const h8*)(P + (tokbase + s + 2) * PP + PC_S5 + g * 16 + co); }
    else { const hf* hp = hin + ((size_t)cidx * 16 + g) * 256 + (k2 - 8) * 32 + fq * 8; b0 = *(const h8*)hp; b1 = *(const h8*)(hp + 32); }
#pragma unroll
    for (int nt = 0; nt < 16; ++nt) { const hf* wp = W2 + ((size_t)(g * 256 + nt * 16 + fr)) * 512 + k2 * 32 + fq * 8; a0[nt] = *(const h8*)wp; a1[nt] = *(const h8*)(wp + 32); }
#pragma unroll
    for (int nt = 0; nt < 16; ++nt) { acc[nt] = mfma16(a0[nt], b0, acc[nt]); acc[nt] = mfma16(a1[nt], b1, acc[nt]); } }
  h4 o[16];
#pragma unroll
  for (int nt = 0; nt < 16; ++nt) {
#pragma unroll
    for (int r = 0; r < 4; ++r) o[nt][r] = (hf)gelu_tanh(acc[nt][r]); }
  __builtin_amdgcn_wave_barrier();
#pragma unroll
  for (int nt = 0; nt < 16; ++nt) *(h4*)(P + (tokbase + nt) * PP + PC_S5 + g * 16 + fq * 4) = o[nt];
}
__device__ __forceinline__ void s5d_task(const Params& p, int layer, int task, int lane) {
  const int fr = lane & 15, fq = lane >> 4;
  const hf* P = (const hf*)(p.ws + OFF_BIG); const hf* gluT = (const hf*)(p.ws + OFF_SMALL + (size_t)layer * SZ_SMALL); hf* Y = (hf*)(p.ws + OFF_AY);
  const float* gb = p.in[I_GLUB] + layer * 256;
  const size_t tok = (size_t)task * 16 + fr;
  f32x4 acc[16];
#pragma unroll
  for (int i = 0; i < 16; ++i) acc[i] = (f32x4){0.f, 0.f, 0.f, 0.f};
#pragma unroll 1
  for (int k2 = 0; k2 < 8; k2 += 2) { h8 a0[16], a1[16]; const h8 b0 = *(const h8*)(P + tok * PP + PC_S5 + k2 * 32 + fq * 8), b1 = *(const h8*)(P + tok * PP + PC_S5 + k2 * 32 + 32 + fq * 8);
#pragma unroll
    for (int nt = 0; nt < 16; ++nt) { const hf* wp = gluT + (size_t)(nt * 16 + fr) * 256 + k2 * 32 + fq * 8; a0[nt] = *(const h8*)wp; a1[nt] = *(const h8*)(wp + 32); }
#pragma unroll
    for (int nt = 0; nt < 16; ++nt) { acc[nt] = mfma16(a0[nt], b0, acc[nt]); acc[nt] = mfma16(a1[nt], b1, acc[nt]); } }
#pragma unroll
  for (int nt = 0; nt < 16; ++nt) { const int n4 = nt * 16 + fq * 4; const h4 zz = *(const h4*)(P + tok * PP + PC_S5 + n4); const f32x4 b4 = *(const f32x4*)(gb + n4); h4 o;
#pragma unroll
    for (int r = 0; r < 4; ++r) o[r] = (hf)((float)zz[r] * sigmoidf_(acc[nt][r] + b4[r]));
    *(h4*)(Y + tok * DM + n4) = o; }
}

template <int NK32>
__device__ __forceinline__ void wg_gemm256(LAS unsigned char* lds, const hf* W, const int ldw, const h8 (&bf)[NK32], f32x4 (&acc)[16], const int tid, const int fr, const int fq) {
  constexpr int NS = NK32 / 4; h8 st[8];
#pragma unroll
  for (int j = 0; j < 8; ++j) { const int idx = tid + 512 * j; st[j] = *(const h8*)(W + (size_t)(idx >> 4) * ldw + (idx & 15) * 8); }
#pragma unroll
  for (int s = 0; s < NS; ++s) {
    __syncthreads();
#pragma unroll
    for (int j = 0; j < 8; ++j) { const int idx = tid + 512 * j; *(LAS h8*)(lds + (idx >> 4) * 272 + (idx & 15) * 16) = st[j]; }
    if (s + 1 < NS) {
#pragma unroll
      for (int j = 0; j < 8; ++j) { const int idx = tid + 512 * j; st[j] = *(const h8*)(W + (size_t)(idx >> 4) * ldw + (s + 1) * 128 + (idx & 15) * 8); } }
    __syncthreads();
#pragma unroll
    for (int ks = 0; ks < 4; ++ks)
#pragma unroll
      for (int nt = 0; nt < 16; ++nt) acc[nt] = mfma16(*(const LAS h8*)(lds + (nt * 16 + fr) * 272 + ks * 64 + fq * 16), bf[s * 4 + ks], acc[nt]);
  }
}
__device__ __forceinline__ void s5a_wg(const int wvs, const Params& p, LAS unsigned char* lds, int layer, int task) {
  const int tid = ltid(wvs), wv = tid >> 6, lane = tid & 63, fr = lane & 15, fq = lane >> 4;
  const hf* P = (const hf*)(p.ws + OFF_BIG); const hf* W1 = (const hf*)(p.ws + OFF_S5W1 + (size_t)layer * SZ_S5W1); hf* hend = (hf*)(p.ws + OFF_HEND);
  const int g = task & 15, cgi = (task >> 4) * 8 + wv; const bool valid = cgi < 68; const int cidx = (valid ? cgi : 0) * 16 + fr, b = cidx / NCH16, n = cidx - b * NCH16; const size_t tokbase = (size_t)b * TPB + n * 16;
  h8 bf[8]; f32x4 acc[16];
#pragma unroll
  for (int i = 0; i < 16; ++i) acc[i] = (f32x4){0.f, 0.f, 0.f, 0.f};
#pragma unroll
  for (int ks = 0; ks < 8; ++ks) { const int s = ks * 2 + (fq >> 1), co = (fq & 1) * 8; bf[ks] = *(const h8*)(P + (tokbase + s) * PP + PC_S5 + g * 16 + co); }
  wg_gemm256<8>(lds, W1 + (size_t)g * 256 * 256, 256, bf, acc, tid, fr, fq);
  if (valid) {
#pragma unroll
    for (int nt = 0; nt < 16; ++nt) { h4 o; o[0] = (hf)acc[nt][0]; o[1] = (hf)acc[nt][1]; o[2] = (hf)acc[nt][2]; o[3] = (hf)acc[nt][3]; *(h4*)(hend + ((size_t)cidx * 16 + g) * 256 + nt * 16 + fq * 4) = o; } }
}
__device__ __forceinline__ void s5c_wg(const int wvs, const Params& p, LAS unsigned char* lds, int layer, int task) {
  const int tid = ltid(wvs), wv = tid >> 6, lane = tid & 63, fr = lane & 15, fq = lane >> 4;
  hf* P = (hf*)(p.ws + OFF_BIG); const hf* W2 = (const hf*)(p.ws + OFF_S5W2 + (size_t)layer * SZ_S5W2); const hf* hin = (const hf*)(p.ws + OFF_HEND);
  const int g = task & 15, cgi = (task >> 4) * 8 + wv; const bool valid = cgi < 68; const int cidx = (valid ? cgi : 0) * 16 + fr, b = cidx / NCH16, n = cidx - b * NCH16; const size_t tokbase = (size_t)b * TPB + n * 16;
  h8 bf[16]; f32x4 acc[16];
#pragma unroll
  for (int i = 0; i < 16; ++i) acc[i] = (f32x4){0.f, 0.f, 0.f, 0.f};
#pragma unroll
  for (int ks = 0; ks < 8; ++ks) { const int s = ks * 2 + (fq >> 1), co = (fq & 1) * 8; bf[ks] = *(const h8*)(P + (tokbase + s) * PP + PC_S5 + g * 16 + co);
    bf[8 + ks] = *(const h8*)(hin + ((size_t)cidx * 16 + g) * 256 + ks * 32 + fq * 8); }
  wg_gemm256<16>(lds, W2 + (size_t)g * 256 * 512, 512, bf, acc, tid, fr, fq);
  if (valid) {
#pragma unroll
    for (int nt = 0; nt < 16; ++nt) { h4 o;
#pragma unroll
      for (int r = 0; r < 4; ++r) o[r] = (hf)gelu_tanh(acc[nt][r]);
      *(h4*)(P + (tokbase + nt) * PP + PC_S5 + g * 16 + fq * 4) = o; } }
}
__device__ __forceinline__ void s5d_wg(const int wvs, const Params& p, LAS unsigned char* lds, int layer, int task) {
  const int tid = ltid(wvs), wv = tid >> 6, lane = tid & 63, fr = lane & 15, fq = lane >> 4;
  const hf* P = (const hf*)(p.ws + OFF_BIG); const hf* gluT = (const hf*)(p.ws + OFF_SMALL + (size_t)layer * SZ_SMALL); hf* Y = (hf*)(p.ws + OFF_AY);
  const float* gb = p.in[I_GLUB] + layer * 256;
  const size_t tok = (size_t)task * 128 + wv * 16 + fr;
  h8 bf[8]; f32x4 acc[16];
#pragma unroll
  for (int i = 0; i < 16; ++i) acc[i] = (f32x4){0.f, 0.f, 0.f, 0.f};
#pragma unroll
  for (int ks = 0; ks < 8; ++ks) bf[ks] = *(const h8*)(P + tok * PP + PC_S5 + ks * 32 + fq * 8);
  wg_gemm256<8>(lds, gluT, 256, bf, acc, tid, fr, fq);
#pragma unroll
  for (int nt = 0; nt < 16; ++nt) { const int n4 = nt * 16 + fq * 4; const h4 zz = *(const h4*)(P + tok * PP + PC_S5 + n4); const f32x4 b4 = *(const f32x4*)(gb + n4); h4 o;
#pragma unroll
    for (int r = 0; r < 4; ++r) o[r] = (hf)((float)zz[r] * sigmoidf_(acc[nt][r] + b4[r]));
    *(h4*)(Y + tok * DM + n4) = o; }
}

__device__ __forceinline__ void gda_task(const Params& p, int layer, int task, int lane) {
  const hf* P = (const hf*)(p.ws + OFF_BIG); hf* GQK = (hf*)(p.ws + OFF_GQK); hf* GV = (hf*)(p.ws + OFF_GV); float* BG = (float*)(p.ws + OFF_BG);
  const float* cw = p.in[I_GCONV] + (size_t)layer * 5 * 1152;
  const int h = task % 6, n = (task / 6) % NCH64, b = task / (6 * NCH64); const int pos0 = n * 64, seg_lo = n < 4 ? 0 : LCTX, seg_hi = n < 4 ? LCTX : TPB;
  float w[3][5], win[3][5];
#pragma unroll
  for (int s = 0; s < 3; ++s)
#pragma unroll
    for (int j = 0; j < 5; ++j) w[s][j] = cw[j * 1152 + s * 384 + h * 64 + lane];
  const size_t tb = (size_t)b * TPB;
#pragma unroll
  for (int j = 0; j < 4; ++j) { const int ps = pos0 - 2 + j; const bool ok = ps >= seg_lo && ps < seg_hi;
#pragma unroll
    for (int s = 0; s < 3; ++s) win[s][j + 1] = ok ? (float)P[(tb + ps) * PP + PC_GQ + s * 384 + h * 64 + lane] : 0.f; }
  hf ring[8][3];
#pragma unroll
  for (int u = 0; u < 8; ++u) { const int ps = pos0 + u + 2; const bool ok = ps < seg_hi;
#pragma unroll
    for (int s = 0; s < 3; ++s) ring[u][s] = ok ? P[(tb + ps) * PP + PC_GQ + s * 384 + h * 64 + lane] : (hf)0.f; }
#pragma unroll 1
  for (int i0 = 0; i0 < 64; i0 += 8) {
    hf cur[8][3];
#pragma unroll
    for (int u = 0; u < 8; ++u)
#pragma unroll
      for (int s = 0; s < 3; ++s) cur[u][s] = ring[u][s];
    if (i0 + 8 < 64) {
#pragma unroll
      for (int u = 0; u < 8; ++u) { const int ps = pos0 + i0 + 8 + u + 2; const bool ok = ps < seg_hi;
#pragma unroll
        for (int s = 0; s < 3; ++s) ring[u][s] = ok ? P[(tb + ps) * PP + PC_GQ + s * 384 + h * 64 + lane] : (hf)0.f; } }
#pragma unroll
    for (int u = 0; u < 8; ++u) { const int pos = pos0 + i0 + u; float o[3];
#pragma unroll
      for (int s = 0; s < 3; ++s) { win[s][0] = win[s][1]; win[s][1] = win[s][2]; win[s][2] = win[s][3]; win[s][3] = win[s][4]; win[s][4] = (float)cur[u][s];
        float a = 0.f;
#pragma unroll
        for (int j = 0; j < 5; ++j) a += w[s][j] * win[s][j];
        o[s] = siluf_(a); }
      const float sq = wave_sum(o[0] * o[0]), sk = wave_sum(o[1] * o[1]);
      o[0] *= rsqrtf(sq + 1e-6f) * 0.125f; o[1] *= rsqrtf(sk + 1e-6f);
      hf* dst = GQK + (tb + pos) * 768 + h * 64 + lane; dst[0] = (hf)o[0]; dst[384] = (hf)o[1]; GV[(tb + pos) * 384 + h * 64 + lane] = (hf)o[2]; } }
  if (h == 0) { const size_t tok = tb + pos0 + lane;
    for (int j = 0; j < 12; ++j) { BG[tok * 24 + j] = sigmoidf_((float)P[tok * PP + PC_BETA + j]);
      BG[tok * 24 + 12 + j] = -expf(p.in[I_GALOG][layer * 12 + j]) * softplusf_((float)P[tok * PP + PC_A + j] + p.in[I_GDTB][layer * 12 + j]); } }
}
__device__ __forceinline__ void phase_x1(const int wvs, const Params& p, LAS unsigned char* lds, int layer) {
  const int bid = lbid();
  if (bid < 52) { for (int task = bid; task < 144; task += 52) s5a_wg(wvs, p, lds, layer, task); }
  else { const int lane = ltid(wvs) & 63; gda_task(p, layer, (bid - 52) * 8 + (ltid(wvs) >> 6), lane); }
}
__device__ __forceinline__ void phase_gdb(const int wvs, const Params& p, LAS unsigned char* lds, int nwg) {
  constexpr int RP = 136, SLOT = 16384 + 64 * RP * 2 + 768;
  const int tid = ltid(wvs), tq = tid >> 7, t = tid & 127, lane = tid & 63, w2 = (tid >> 6) & 1, fr = lane & 15, fq = lane >> 4;
  LAS float* M = (LAS float*)(lds + tq * SLOT); LAS hf* R = (LAS hf*)(lds + tq * SLOT + 16384); LAS float* gs = (LAS float*)(lds + tq * SLOT + 16384 + 64 * RP * 2); LAS float* bs = gs + 64; LAS float* gcs = bs + 64;
  hf* P = (hf*)(p.ws + OFF_BIG); const hf* GQK = (const hf*)(p.ws + OFF_GQK); const hf* GV = (const hf*)(p.ws + OFF_GV); const float* BG = (const float*)(p.ws + OFF_BG); hf* WB = (hf*)(p.ws + OFF_WB);
  const int rr = t >> 4, cc = (t & 15) * 8;
  if (lbid() >= nwg) return;
  for (int grp = lbid(); grp < NB * NCH64 * 12 / 4; grp += nwg) {
    const int task = grp * 4 + tq, d = task & 1, h = (task >> 1) % 6, n = (task / 12) % NCH64, b = task / (12 * NCH64);
    const size_t tokbase = (size_t)b * TPB + n * 64;
#define TOKI(i) (tokbase + (d ? 63 - (i) : (i)))
    if (t < 64) { gs[t] = BG[TOKI(t) * 24 + 12 + d * 6 + h]; bs[t] = BG[TOKI(t) * 24 + d * 6 + h]; }
    { h8 rv[8];
#pragma unroll
      for (int ps = 0; ps < 8; ++ps) { const int i = ps * 8 + rr; const hf* srcp = cc < 64 ? GV + TOKI(i) * 384 + h * 64 + cc : GQK + TOKI(i) * 768 + 384 + h * 64 + cc - 64; rv[ps] = *(const h8*)srcp; }
#pragma unroll
      for (int ps = 0; ps < 8; ++ps) *(LAS h8*)(R + (ps * 8 + rr) * RP + cc) = rv[ps]; }
    __syncthreads();
    if (t < 64) { float s = gs[t];
#define GD_DPP(ctrl, rmask) s += __builtin_bit_cast(float, __builtin_amdgcn_update_dpp(0, __builtin_bit_cast(int, s), ctrl, rmask, 0xF, true))
      GD_DPP(0x111, 0xF); GD_DPP(0x112, 0xF); GD_DPP(0x114, 0xF); GD_DPP(0x118, 0xF); GD_DPP(0x142, 0xA); GD_DPP(0x143, 0xC);
#undef GD_DPP
      gcs[t] = s; ((float*)(p.ws + OFF_BG))[TOKI(t) * 24 + 12 + d * 6 + h] = s; }
    __syncthreads();
#pragma unroll 1
    for (int tl = w2 * 5; tl < w2 * 5 + 5; ++tl) { const int ti = tl < 1 ? 0 : tl < 3 ? 1 : tl < 6 ? 2 : 3, tj = tl - (ti * (ti + 1)) / 2;
      f32x4 acc = {0.f, 0.f, 0.f, 0.f};
#pragma unroll
      for (int ks = 0; ks < 2; ++ks) { const h8 af = *(const LAS h8*)(R + (ti * 16 + fr) * RP + 64 + ks * 32 + fq * 8); const h8 bf = *(const LAS h8*)(R + (tj * 16 + fr) * RP + 64 + ks * 32 + fq * 8);
        acc = mfma16(af, bf, acc); }
#pragma unroll
      for (int r = 0; r < 4; ++r) { const int i = ti * 16 + fq * 4 + r, j = tj * 16 + fr; M[i * 64 + j] = (j < i) ? bs[i] * acc[r] * __expf(gcs[i] - gcs[j]) : 0.f; } }
    __syncthreads();
    { float x[64]; const bool isw = t >= 64;
#pragma unroll
      for (int i = 0; i < 64; ++i) { const float v = (float)R[i * RP + t]; x[i] = v * bs[i] * (isw ? __expf(gcs[i]) : 1.0f); asm volatile("" : "+v"(x[i])); if ((i & 7) == 7) __builtin_amdgcn_sched_barrier(0); }
#pragma unroll
      for (int i = 1; i < 64; ++i) {
#pragma unroll
        for (int j4 = 0; j4 < (i + 3) / 4; ++j4) { const f32x4 m4 = *(const LAS f32x4*)(M + i * 64 + j4 * 4);
#pragma unroll
          for (int jj = 0; jj < 4; ++jj) if (j4 * 4 + jj < i) x[i] -= m4[jj] * x[j4 * 4 + jj]; }
        __builtin_amdgcn_sched_barrier(0); }
#pragma unroll
      for (int i = 0; i < 64; ++i) R[i * RP + t] = (hf)x[i]; }
    __syncthreads();
#undef TOKI
    { int tid2 = tid; asm volatile("" : "+v"(tid2));
      const int tq2 = tid2 >> 7, t2 = tid2 & 127, rr2 = t2 >> 4, cc2 = (t2 & 15) * 8; LAS hf* R2 = (LAS hf*)(lds + tq2 * SLOT + 16384);
      const int task2 = grp * 4 + tq2, d2 = task2 & 1, h2 = (task2 >> 1) % 6, n2 = (task2 / 12) % NCH64, b2 = task2 / (12 * NCH64); const size_t tokbase2 = (size_t)b2 * TPB + n2 * 64;
#pragma unroll 1
      for (int ps = 0; ps < 8; ++ps) { const int i = ps * 8 + rr2; const h8 v = *(const LAS h8*)(R2 + i * RP + cc2); const size_t tk = tokbase2 + (d2 ? 63 - i : i);
        hf* dst = cc2 < 64 ? P + tk * PP + (d2 ? PC_GV : PC_GQ) + h2 * 64 + cc2 : (d2 == 0 ? P + tk * PP + PC_GK + h2 * 64 + cc2 - 64 : WB + tk * 384 + h2 * 64 + cc2 - 64);
        *(h8*)dst = v; } }
    __syncthreads();
  }
}
__device__ __forceinline__ void phase_gdc(const int wvs, const Params& p, LAS unsigned char* lds, int wg0) {
  const int wgi = lbid() - wg0; if (wgi < 0 || wgi >= NB * 12) return;
  constexpr int LP = 72, ARR = 64 * LP;
  const int tid = ltid(wvs), wv = tid >> 6, lane = tid & 63, fr = lane & 15, fq = lane >> 4;
  const int d = wgi & 1, h = (wgi >> 1) % 6, b = wgi / 12;
  LAS hf* QKb = (LAS hf*)lds;
  LAS hf* VnT = QKb + 6 * ARR; LAS hf* At = VnT + ARR; LAS hf* ST0 = At + ARR; LAS hf* ST1 = ST0 + ARR;
  LAS float* gcb = (LAS float*)(ST1 + ARR);
  hf* P = (hf*)(p.ws + OFF_BIG); const hf* GQK = (const hf*)(p.ws + OFF_GQK); const float* BG = (const float*)(p.ws + OFF_BG); const hf* WB = (const hf*)(p.ws + OFF_WB);
  const int ucol = (d ? PC_GV : PC_GQ) + h * 64;
  const int ti = wv >> 1, tv0 = (wv & 1) * 2;
  const int li = tid >> 3, k8 = (tid & 7) * 8;
  f32x4 Sacc[2] = {{0.f, 0.f, 0.f, 0.f}, {0.f, 0.f, 0.f, 0.f}};
  for (int i = tid; i < ARR; i += 512) { ST0[i] = (hf)0.f; ST1[i] = (hf)0.f; }
  h8 pq, pk, pwa[2]; float pgi, pgl, pg; hf pu[2][4];
#define GD_CHUNK(cn) (d == 0 ? (cn) : ((cn) < 4 ? 3 - (cn) : 71 - (cn)))
#define GD_PREFETCH(cn) { const size_t tb_ = (size_t)b * TPB + GD_CHUNK(cn) * 64; const int gcol = 12 + d * 6 + h; \
    { const size_t tk = tb_ + (d ? 63 - li : li); pq = *(const h8*)(GQK + tk * 768 + h * 64 + k8); pk = *(const h8*)(GQK + tk * 768 + 384 + h * 64 + k8); pgi = BG[tk * 24 + gcol]; } \
    pgl = BG[(tb_ + (d ? 0 : 63)) * 24 + gcol]; pg = BG[(tb_ + (d ? 63 - (tid & 63) : (tid & 63))) * 24 + gcol]; \
    { const size_t tk = tb_ + (d ? 63 - (ti * 16 + fr) : (ti * 16 + fr)); _Pragma("unroll") for (int ks = 0; ks < 2; ++ks) \
        pwa[ks] = d == 0 ? *(const h8*)(P + tk * PP + PC_GK + h * 64 + ks * 32 + fq * 8) : *(const h8*)(WB + tk * 384 + h * 64 + ks * 32 + fq * 8); } \
    _Pragma("unroll") for (int t2 = 0; t2 < 2; ++t2) _Pragma("unroll") for (int r = 0; r < 4; ++r) { const int i_ = ti * 16 + fq * 4 + r; pu[t2][r] = P[(tb_ + (d ? 63 - i_ : i_)) * PP + ucol + (tv0 + t2) * 16 + fr]; } }
  GD_PREFETCH(0)
#pragma unroll 1
  for (int cn = 0; cn < NCH64; ++cn) {
    const size_t tokbase = (size_t)b * TPB + GD_CHUNK(cn) * 64;
    LAS hf* Qs = QKb + (cn & 1) * 3 * ARR; LAS hf* Ks = Qs + ARR; LAS hf* KdT = Ks + ARR; LAS float* gcm = gcb + (cn & 1) * 64;
    LAS hf* STr = (cn & 1) ? ST1 : ST0; LAS hf* STw = (cn & 1) ? ST0 : ST1;
#define TOKI(i) (tokbase + (d ? 63 - (i) : (i)))
    const float glast = pgl;
    if (tid < 64) gcm[tid] = pg;
    { *(LAS h8*)(Qs + li * LP + k8) = pq; *(LAS h8*)(Ks + li * LP + k8) = pk; const float sc = __expf(glast - pgi);
#pragma unroll
      for (int j = 0; j < 8; ++j) KdT[(k8 + j) * LP + li] = (hf)((float)pk[j] * sc); }
    h8 wa[2] = {pwa[0], pwa[1]}; hf cu[2][4];
#pragma unroll
    for (int t2 = 0; t2 < 2; ++t2)
#pragma unroll
      for (int r = 0; r < 4; ++r) cu[t2][r] = pu[t2][r];
    __syncthreads();
    if (cn + 1 < NCH64) GD_PREFETCH(cn + 1)
#pragma unroll
    for (int t2 = 0; t2 < 2; ++t2) { const int tv = tv0 + t2; f32x4 acc = {0.f, 0.f, 0.f, 0.f};
#pragma unroll
      for (int ks = 0; ks < 2; ++ks) { const h8 bf = *(const LAS h8*)(STr + (tv * 16 + fr) * LP + ks * 32 + fq * 8); acc = mfma16(wa[ks], bf, acc); }
      h4 o;
#pragma unroll
      for (int r = 0; r < 4; ++r) o[r] = (hf)((float)cu[t2][r] - acc[r]);
      *(LAS h4*)(VnT + (tv * 16 + fr) * LP + ti * 16 + fq * 4) = o; }
#pragma unroll
    for (int t2 = 0; t2 < 2; ++t2) { const int tj = tv0 + t2; h4 o = {(hf)0.f, (hf)0.f, (hf)0.f, (hf)0.f};
      if (tj <= ti) { f32x4 acc = {0.f, 0.f, 0.f, 0.f};
#pragma unroll
        for (int ks = 0; ks < 2; ++ks) { const h8 af = *(const LAS h8*)(Ks + (tj * 16 + fr) * LP + ks * 32 + fq * 8); const h8 bf = *(const LAS h8*)(Qs + (ti * 16 + fr) * LP + ks * 32 + fq * 8); acc = mfma16(af, bf, acc); }
        const int i = ti * 16 + fr; const float gi = gcm[i];
#pragma unroll
        for (int r = 0; r < 4; ++r) { const int j = tj * 16 + fq * 4 + r; o[r] = (hf)((j <= i) ? acc[r] * __expf(gi - gcm[j]) : 0.f); } }
      *(LAS h4*)(At + (ti * 16 + fr) * LP + tj * 16 + fq * 4) = o; }
    __syncthreads();
#pragma unroll
    for (int t2 = 0; t2 < 2; ++t2) { const int tv = tv0 + t2; f32x4 a1 = {0.f, 0.f, 0.f, 0.f}, a2 = {0.f, 0.f, 0.f, 0.f};
#pragma unroll
      for (int ks = 0; ks < 2; ++ks) { const h8 bq = *(const LAS h8*)(Qs + (ti * 16 + fr) * LP + ks * 32 + fq * 8); const h8 as = *(const LAS h8*)(STr + (tv * 16 + fr) * LP + ks * 32 + fq * 8); a1 = mfma16(as, bq, a1);
        const h8 ba = *(const LAS h8*)(At + (ti * 16 + fr) * LP + ks * 32 + fq * 8); const h8 av = *(const LAS h8*)(VnT + (tv * 16 + fr) * LP + ks * 32 + fq * 8); a2 = mfma16(av, ba, a2); }
      const int i = ti * 16 + fr; const float eg = __expf(gcm[i]); h4 o;
#pragma unroll
      for (int r = 0; r < 4; ++r) o[r] = (hf)(eg * a1[r] + a2[r]);
      *(h4*)(P + TOKI(i) * PP + ucol + tv * 16 + fq * 4) = o; }
    { const float egl = __expf(glast); const int tk = ti;
#pragma unroll
      for (int t2 = 0; t2 < 2; ++t2) { const int tv = tv0 + t2; f32x4 acc = Sacc[t2] * egl;
#pragma unroll
        for (int ks = 0; ks < 2; ++ks) { const h8 af = *(const LAS h8*)(KdT + (tk * 16 + fr) * LP + ks * 32 + fq * 8); const h8 bf = *(const LAS h8*)(VnT + (tv * 16 + fr) * LP + ks * 32 + fq * 8); acc = mfma16(af, bf, acc); }
        Sacc[t2] = acc; h4 o;
#pragma unroll
        for (int r = 0; r < 4; ++r) o[r] = (hf)acc[r];
        *(LAS h4*)(STw + (tv * 16 + fr) * LP + tk * 16 + fq * 4) = o; } }
#undef TOKI
  }
#undef GD_PREFETCH
#undef GD_CHUNK
}
__device__ __forceinline__ void phase_gdd(const int wvs, const Params& p, int layer) {
  const int lane = ltid(wvs) & 63, gw = lbid() * 8 + (ltid(wvs) >> 6);
  const hf* P = (const hf*)(p.ws + OFF_BIG); hf* Y = (hf*)(p.ws + OFF_AY); const float nw = p.in[I_GNORM][layer * 64 + lane];
  for (int tok0 = gw * 2; tok0 < NTOK; tok0 += NWAVES * 2) {
    hf a[2][6], bq[2][6], zz[2][6];
#pragma unroll
    for (int u = 0; u < 2; ++u) { const hf* pr = P + (size_t)(tok0 + u) * PP;
#pragma unroll
      for (int m = 0; m < 6; ++m) { a[u][m] = pr[PC_GQ + m * 64 + lane]; bq[u][m] = pr[PC_GV + m * 64 + lane]; zz[u][m] = pr[PC_GZ + m * 64 + lane]; } }
#pragma unroll
    for (int u = 0; u < 2; ++u) { float o[6], ss[6];
#pragma unroll
      for (int m = 0; m < 6; ++m) { o[m] = (float)a[u][m] + (float)bq[u][m]; ss[m] = wave_sum(o[m] * o[m]); }
#pragma unroll
      for (int m = 0; m < 6; ++m) Y[(size_t)(tok0 + u) * DM + 256 + m * 64 + lane] = (hf)(o[m] * rsqrtf(ss[m] * (1.f / 64.f) + 1e-6f) * nw * siluf_((float)zz[u][m])); } }
}

__device__ __forceinline__ void phase_rwa(const int wvs, const Params& p, int layer) {
  const int lane = ltid(wvs) & 63, gw = lbid() * 8 + (ltid(wvs) >> 6);
  hf* P = (hf*)(p.ws + OFF_BIG); hf* RL1 = (hf*)(p.ws + OFF_RL1); hf* RL3 = (hf*)(p.ws + OFF_RL3); float* INVN = (float*)(p.ws + OFF_INVN);
  const float* mu = p.in[I_MU] + layer * 1536; const float* kkw = p.in[I_KK] + layer * 384;
  int t0, tq;
  if (gw < 768) { t0 = 3 * gw; tq = 3; } else if (gw < 1920) { t0 = 2304 + 11 * (gw - 768); tq = 11; } else { t0 = 14976 + 19 * (gw - 1920); tq = 19; }
#define RWA_NB(tok_, nb_) { const int b_ = (tok_) / TPB, pos_ = (tok_) - b_ * TPB; const int dsel = lane & 3; \
    if (pos_ < LCTX) { nb_ = (dsel & 1) == 0 ? (pos_ >= 1 ? (tok_) - 1 : -1) : (pos_ + 1 < LCTX ? (tok_) + 1 : -1); } \
    else { const int s_ = pos_ - LCTX, row_ = s_ >> 6, cx_ = s_ & 63; \
      nb_ = dsel == 0 ? (cx_ > 0 ? (tok_) - 1 : -1) : dsel == 1 ? (cx_ < 63 ? (tok_) + 1 : -1) : dsel == 2 ? (row_ > 0 ? (tok_) - 64 : -1) : (row_ < 63 ? (tok_) + 64 : -1); } }
#define RWA_LOAD(tok_, nb_, pv_, sv_) { const hf* pr_ = P + (size_t)(tok_) * PP + PC_RW; const hf* pn_ = P + (size_t)((nb_) < 0 ? (tok_) : (nb_)) * PP + PC_RW; \
    _Pragma("unroll") for (int m = 0; m < 24; ++m) { pv_[m] = pr_[lane + 64 * m]; sv_[m] = pn_[lane + 64 * m]; } }
  hf pv[24], sv[24]; int nb;
  RWA_NB(t0, nb) RWA_LOAD(t0, nb, pv, sv)
#pragma unroll 1
  for (int tok = t0; tok < t0 + tq; ++tok) {
    hf npv[24], nsv[24]; int nnb = -1;
    if (tok + 1 < t0 + tq) { RWA_NB(tok + 1, nnb) RWA_LOAD(tok + 1, nnb, npv, nsv) }
    float val[24];
#pragma unroll
    for (int m = 0; m < 24; ++m) { const int c = lane + 64 * m; const float a = (float)pv[m], s = nb < 0 ? 0.f : (float)sv[m]; val[m] = a + (s - a) * mu[c]; }
    float ss[6];
#pragma unroll
    for (int m = 6; m < 12; ++m) { const float kv = val[m] * kkw[lane + 64 * m - 384]; ss[m - 6] = wave_sum(kv * kv); }
#pragma unroll
    for (int m = 0; m < 24; ++m) { const int c = lane + 64 * m;
      if (m < 18) RL1[(size_t)tok * 1152 + c] = (hf)val[m]; else if (m < 22) P[(size_t)tok * PP + PC_RL2 + (c - 1152)] = (hf)val[m]; else RL3[(size_t)tok * 128 + (c - 1408)] = (hf)val[m]; }
    if (lane < 6) { float s = ss[0];
#pragma unroll
      for (int q = 1; q < 6; ++q) s = lane == q ? ss[q] : s;
      INVN[(size_t)tok * 6 + lane] = rsqrtf(s + 1e-6f); }
#pragma unroll
    for (int m = 0; m < 24; ++m) { pv[m] = npv[m]; sv[m] = nsv[m]; }
    nb = nnb;
  }
#undef RWA_NB
#undef RWA_LOAD
}
__device__ __forceinline__ void phase_rwb(const int wvs, const Params& p, LAS unsigned char* lds, int layer) {
  const int bid = lbid() + 120, tid = ltid(wvs), wv = tid >> 6, lane = tid & 63, fr = lane & 15, fq = lane >> 4;
  if (bid >= 256) return;
  hf* P = (hf*)(p.ws + OFF_BIG);
  const hf* wupT = (const hf*)(p.ws + OFF_SMALL + (size_t)layer * SZ_SMALL + SZ_GLUT); const hf* aupT = (const hf*)(p.ws + OFF_SMALL + (size_t)layer * SZ_SMALL + SZ_GLUT + SZ_WUPT);
  const size_t tok = (size_t)(bid - 120) * 128 + wv * 16 + fr;
  h8 sw[6], sa[6];
#define RWB_FETCH(d_) { _Pragma("unroll") for (int j = 0; j < 6; ++j) { const int idx = tid + 512 * j; const size_t wo = ((size_t)(d_) * 384 + (idx >> 3)) * 64 + (idx & 7) * 8; sw[j] = *(const h8*)(wupT + wo); sa[j] = *(const h8*)(aupT + wo); } }
  RWB_FETCH(0)
#pragma unroll 1
  for (int d = 0; d < 2; ++d) {
    h8 bw[2], ba[2];
#pragma unroll
    for (int ks = 0; ks < 2; ++ks) { const h8 x = *(const h8*)(P + tok * PP + PC_RL2 + d * 64 + ks * 32 + fq * 8);
#pragma unroll
      for (int j = 0; j < 8; ++j) bw[ks][j] = (hf)tanhf_((float)x[j]);
      ba[ks] = *(const h8*)(P + tok * PP + PC_RL2 + 128 + d * 64 + ks * 32 + fq * 8); }
    __syncthreads();
#pragma unroll
    for (int j = 0; j < 6; ++j) { const int idx = tid + 512 * j; *(LAS h8*)(lds + (idx >> 3) * 144 + (idx & 7) * 16) = sw[j]; *(LAS h8*)(lds + 55296 + (idx >> 3) * 144 + (idx & 7) * 16) = sa[j]; }
    if (d == 0) RWB_FETCH(1)
    __syncthreads();
    const float* w0 = p.in[I_W0] + (layer * 2 + d) * 384; const float* a0 = p.in[I_A0] + (layer * 2 + d) * 384;
#pragma unroll 2
    for (int nt = 0; nt < 24; ++nt) { f32x4 aw = {0.f, 0.f, 0.f, 0.f}, aa = {0.f, 0.f, 0.f, 0.f};
      const int n4 = nt * 16 + fq * 4; const f32x4 w04 = *(const f32x4*)(w0 + n4), a04 = *(const f32x4*)(a0 + n4);
#pragma unroll
      for (int ks = 0; ks < 2; ++ks) { aw = mfma16(*(const LAS h8*)(lds + (nt * 16 + fr) * 144 + ks * 64 + fq * 16), bw[ks], aw); aa = mfma16(*(const LAS h8*)(lds + 55296 + (nt * 16 + fr) * 144 + ks * 64 + fq * 16), ba[ks], aa); }
      h4 oe, oa;
#pragma unroll
      for (int r = 0; r < 4; ++r) { const float wl = -softplusf_(-(w04[r] + aw[r])) - 0.5f; oe[r] = (hf)__expf(wl); oa[r] = (hf)sigmoidf_(a04[r] + aa[r]); }
      *(h4*)(P + tok * PP + PC_EF + d * 384 + n4) = oe; *(h4*)(P + tok * PP + PC_AF + d * 384 + n4) = oa; }
  }
}
#undef RWB_FETCH
__device__ __forceinline__ void phase_rwc(const int wvs, const Params& p, LAS unsigned char* lds, int layer, int wg0) {
  const int wgi = lbid() - wg0; if (wgi < 0 || wgi >= NB * 48) return;
  const int tid = ltid(wvs), wv = tid >> 6, lane = tid & 63;
  const int qd = wgi / 48, chain = wgi - qd * 48, d = chain & 1, h = (chain >> 1) % 6, b = chain / 12; const int v0 = qd * 16;
  constexpr int BUFSZ = 5 * 8192 + 2048, NBLK = TPB / 32, YOFF = 2 * BUFSZ, YSZ = 32 * 16 * 16 * 4;
  hf* P = (hf*)(p.ws + OFF_BIG); const hf* RL = (const hf*)(p.ws + OFF_RL1); const float* INVN = (const float*)(p.ws + OFF_INVN);
  const size_t tb = (size_t)b * TPB;
#define RW_POS(s) ((d == 0) ? (s) : ((s) < LCTX ? (LCTX - 1 - (s)) : (TPB + LCTX - 1 - (s))))
  if (wv >= 4) {
    const int pt = tid - 256;
    h4 nr[2], nk[2], ne[2], na[2]; float ninv[2]; h2 nv;
    f32x4 kkw[2], kaw[2];
#pragma unroll
    for (int j = 0; j < 2; ++j) { const int kg = (pt + 256 * j) & 15; kkw[j] = *(const f32x4*)(p.in[I_KK] + layer * 384 + h * 64 + kg * 4); kaw[j] = *(const f32x4*)(p.in[I_KA] + layer * 384 + h * 64 + kg * 4); }
    hf* ybase; long ypitch;
    if (d == 0) { ybase = (hf*)(p.ws + OFF_GV) + h * 64 + v0; ypitch = 384; }
    else if (h < 4) { ybase = P + PC_RL2 + h * 64 + v0; ypitch = PP; }
    else { ybase = (hf*)(p.ws + OFF_YB2) + (h - 4) * 64 + v0; ypitch = 128; }
#define RW_LOAD(blk) { _Pragma("unroll") for (int j = 0; j < 2; ++j) { const int it = pt + 256 * j, tt = it >> 4, k4 = (it & 15) * 4; const size_t tk = tb + RW_POS((blk) * 32 + tt); \
      nr[j] = *(const h4*)(RL + tk * 1152 + h * 64 + k4); nk[j] = *(const h4*)(RL + tk * 1152 + 384 + h * 64 + k4); \
      ne[j] = *(const h4*)(P + tk * PP + PC_EF + d * 384 + h * 64 + k4); na[j] = *(const h4*)(P + tk * PP + PC_AF + d * 384 + h * 64 + k4); ninv[j] = INVN[tk * 6 + h]; } \
      { const size_t tk = tb + RW_POS((blk) * 32 + (pt >> 3)); nv = *(const h2*)(RL + tk * 1152 + 768 + h * 64 + v0 + (pt & 7) * 2); } }
#define RW_DERIVE(bufi) { LAS float* Wv = (LAS float*)(lds + (bufi) * BUFSZ); LAS float* KKv = Wv + 2048; LAS float* Bv = KKv + 2048; LAS float* KDv = Bv + 2048; LAS float* Rv = KDv + 2048; LAS float* Vv = Rv + 2048; \
      _Pragma("unroll") for (int j = 0; j < 2; ++j) { const int it = pt + 256 * j, tt = it >> 4, k4 = (it & 15) * 4; f32x4 w4, kk4, b4, kd4, r4; \
        _Pragma("unroll") for (int q = 0; q < 4; ++q) { const float kf = (float)nk[j][q], a = (float)na[j][q]; w4[q] = __expf(-(float)ne[j][q]); const float kk = kf * kkw[j][q] * ninv[j]; kk4[q] = kk; b4[q] = -(kk * a); kd4[q] = kf * (1.f + (a - 1.f) * kaw[j][q]); r4[q] = (float)nr[j][q]; } \
        *(LAS f32x4*)(Wv + tt * 64 + k4) = w4; *(LAS f32x4*)(KKv + tt * 64 + k4) = kk4; *(LAS f32x4*)(Bv + tt * 64 + k4) = b4; *(LAS f32x4*)(KDv + tt * 64 + k4) = kd4; *(LAS f32x4*)(Rv + tt * 64 + k4) = r4; } \
      Vv[(pt >> 3) * 16 + (pt & 7) * 2] = (float)nv[0]; Vv[(pt >> 3) * 16 + (pt & 7) * 2 + 1] = (float)nv[1]; }
#define RW_YOUT(yb) { const LAS float* yp_ = (const LAS float*)(lds + YOFF + ((yb) & 1) * YSZ); _Pragma("unroll") for (int j = 0; j < 2; ++j) { const int o = pt + 256 * j, t_ = o >> 4, row = o & 15; \
      const f32x4 a0 = *(const LAS f32x4*)(yp_ + o * 16), a1 = *(const LAS f32x4*)(yp_ + o * 16 + 4), a2 = *(const LAS f32x4*)(yp_ + o * 16 + 8), a3 = *(const LAS f32x4*)(yp_ + o * 16 + 12); \
      const f32x4 s4 = (a0 + a1) + (a2 + a3); const float y = (s4[0] + s4[1]) + (s4[2] + s4[3]); \
      ybase[(long)(tb + RW_POS((yb) * 32 + t_)) * ypitch + row] = (hf)y; } }
    RW_LOAD(0) RW_DERIVE(0) RW_LOAD(1)
    __syncthreads();
#pragma unroll 2
    for (int blk = 0; blk < NBLK; ++blk) {
      if (blk + 1 < NBLK) RW_DERIVE((blk + 1) & 1)
      if (blk + 2 < NBLK) RW_LOAD(blk + 2)
      if (blk >= 1) RW_YOUT(blk - 1)
      __syncthreads();
    }
    RW_YOUT(NBLK - 1)
#undef RW_LOAD
#undef RW_DERIVE
#undef RW_YOUT
  } else {
    const int rowl = wv * 4 + (lane >> 4), kg = lane & 15;
    f32x4 S = {0.f, 0.f, 0.f, 0.f};
    __syncthreads();
#pragma unroll 2
    for (int blk = 0; blk < NBLK; ++blk) {
      LAS float* Wv = (LAS float*)(lds + (blk & 1) * BUFSZ) + kg * 4; LAS float* Vv = (LAS float*)(lds + (blk & 1) * BUFSZ) + 5 * 2048 + rowl;
      LAS float* ypw = (LAS float*)(lds + YOFF + (blk & 1) * YSZ) + rowl * 16 + kg;
      asm volatile("" : "+v"(Wv), "+v"(Vv), "+v"(ypw));
      f32x4 w4 = *(const LAS f32x4*)(Wv), kk4 = *(const LAS f32x4*)(Wv + 2048), b4 = *(const LAS f32x4*)(Wv + 4096), kd4 = *(const LAS f32x4*)(Wv + 6144), r4 = *(const LAS f32x4*)(Wv + 8192); float vv = Vv[0];
      f32x4 xw4 = *(const LAS f32x4*)(Wv + 64), xkk4 = *(const LAS f32x4*)(Wv + 2048 + 64), xb4 = *(const LAS f32x4*)(Wv + 4096 + 64), xkd4 = *(const LAS f32x4*)(Wv + 6144 + 64), xr4 = *(const LAS f32x4*)(Wv + 8192 + 64); float xvv = Vv[16];
#pragma unroll 16
      for (int t = 0; t < 32; ++t) {
        const int tn = t + 2;
        const f32x4 nw4 = *(const LAS f32x4*)(Wv + tn * 64), nkk4 = *(const LAS f32x4*)(Wv + 2048 + tn * 64), nb4 = *(const LAS f32x4*)(Wv + 4096 + tn * 64), nkd4 = *(const LAS f32x4*)(Wv + 6144 + tn * 64), nr4 = *(const LAS f32x4*)(Wv + 8192 + tn * 64);
        const float nvv = Vv[tn * 16];
        const f32x4 pa = S * kk4;
        const f32x4 t1 = S * w4 + vv * kd4;
        float sa = (pa[0] + pa[2]) + (pa[1] + pa[3]);
        sa = row16_sum(sa);
        S = t1 + sa * b4;
        const f32x4 py = S * r4;
        ypw[t * 256] = (py[0] + py[2]) + (py[1] + py[3]);
        w4 = xw4; kk4 = xkk4; b4 = xb4; kd4 = xkd4; r4 = xr4; vv = xvv;
        xw4 = nw4; xkk4 = nkk4; xb4 = nb4; xkd4 = nkd4; xr4 = nr4; xvv = nvv;
      }
      __syncthreads();
    }
  }
#undef RW_POS
}
__device__ __forceinline__ void phase_rwd(const int wvs, const Params& p, int layer) {
  const int lane = ltid(wvs) & 63, gw = lbid() * 8 + (ltid(wvs) >> 6), fr = lane & 15, fq = lane >> 4;
  const hf* P = (const hf*)(p.ws + OFF_BIG); const hf* RL = (const hf*)(p.ws + OFF_RL1); const hf* RL3 = (const hf*)(p.ws + OFF_RL3); hf* Y = (hf*)(p.ws + OFF_AY);
  const hf* gupT = (const hf*)(p.ws + OFF_SMALL + (size_t)layer * SZ_SMALL + SZ_GLUT + 2 * SZ_WUPT);
  for (int task = gw; task < (NTOK / 16) * 6; task += NWAVES) { const int h = task % 6; const size_t tok = (size_t)(task / 6) * 16 + fr;
    h8 bg[4];
#pragma unroll
    for (int ks = 0; ks < 4; ++ks) { const h8 x = *(const h8*)(RL3 + tok * 128 + ks * 32 + fq * 8);
#pragma unroll
      for (int j = 0; j < 8; ++j) bg[ks][j] = (hf)sigmoidf_((float)x[j]); }
    f32x4 gate[4]; float y[4][4]; float ssum = 0.f, bon = 0.f; h4 vv[4];
#pragma unroll
    for (int nt = 0; nt < 4; ++nt) { f32x4 acc = {0.f, 0.f, 0.f, 0.f};
#pragma unroll
      for (int ks = 0; ks < 4; ++ks) acc = mfma16(*(const h8*)(gupT + (size_t)(h * 64 + nt * 16 + fr) * 128 + ks * 32 + fq * 8), bg[ks], acc);
      gate[nt] = acc; const int ch = h * 64 + nt * 16 + fq * 4;
      const h4 yf = *(const h4*)((const hf*)(p.ws + OFF_GV) + tok * 384 + ch), yb = h < 4 ? *(const h4*)(P + tok * PP + PC_RL2 + ch) : *(const h4*)((const hf*)(p.ws + OFF_YB2) + tok * 128 + ch - 256), rr = *(const h4*)(RL + tok * 1152 + ch), kk = *(const h4*)(RL + tok * 1152 + 384 + ch);
      const h4 af = *(const h4*)(P + tok * PP + PC_AF + ch), ab = *(const h4*)(P + tok * PP + PC_AF + 384 + ch); vv[nt] = *(const h4*)(RL + tok * 1152 + 768 + ch);
      const f32x4 ka4 = *(const f32x4*)(p.in[I_KA] + layer * 384 + ch), rk4 = *(const f32x4*)(p.in[I_RK] + layer * 384 + ch);
#pragma unroll
      for (int r = 0; r < 4; ++r) { y[nt][r] = (float)yf[r] + (float)yb[r]; ssum += y[nt][r]; const float kf = (float)kk[r];
        bon += (float)rr[r] * rk4[r] * (kf * (1.f + ((float)af[r] - 1.f) * ka4[r]) + kf * (1.f + ((float)ab[r] - 1.f) * ka4[r])); } }
    ssum += __shfl_xor(ssum, 16); ssum += __shfl_xor(ssum, 32); bon += __shfl_xor(bon, 16); bon += __shfl_xor(bon, 32);
    const float mean = ssum * (1.f / 64.f); float vs = 0.f;
#pragma unroll
    for (int nt = 0; nt < 4; ++nt)
#pragma unroll
      for (int r = 0; r < 4; ++r) { const float dl = y[nt][r] - mean; vs += dl * dl; }
    vs += __shfl_xor(vs, 16); vs += __shfl_xor(vs, 32); const float rstd = rsqrtf(vs * (1.f / 64.f) + 64e-5f);
#pragma unroll
    for (int nt = 0; nt < 4; ++nt) { const int ch = h * 64 + nt * 16 + fq * 4; const f32x4 lw = *(const f32x4*)(p.in[I_LNW] + layer * 384 + ch), lb = *(const f32x4*)(p.in[I_LNB] + layer * 384 + ch); h4 o;
#pragma unroll
      for (int r = 0; r < 4; ++r) o[r] = (hf)((((y[nt][r] - mean) * rstd) * lw[r] + lb[r] + bon * (float)vv[nt][r]) * gate[nt][r]);
      *(h4*)(Y + tok * DM + 640 + ch) = o; }
  }
}

__device__ __forceinline__ void phase_x5(const int wvs, const Params& p, int layer) {
  const int lane = ltid(wvs) & 63, gw = lbid() * 8 + (ltid(wvs) >> 6), fr = lane & 15, fq = lane >> 4;
  const hf* P = (const hf*)(p.ws + OFF_BIG); const hf* RL = (const hf*)(p.ws + OFF_RL1); const hf* RL3 = (const hf*)(p.ws + OFF_RL3); hf* Y = (hf*)(p.ws + OFF_AY);
  const hf* gupT = (const hf*)(p.ws + OFF_SMALL + (size_t)layer * SZ_SMALL + SZ_GLUT + 2 * SZ_WUPT);
  const hf* Pg = (const hf*)(p.ws + OFF_BIG); const float nwg_ = p.in[I_GNORM][layer * 64 + lane];
  const int gwr = NWAVES - 1 - gw;
#pragma unroll 1
  for (int it = 0; it < 5; ++it) {
    const int tok0 = (gwr + it * NWAVES) * 2; const bool gv_ = tok0 < NTOK;
    hf ga[2][6], gb[2][6], gz[2][6];
    if (gv_) {
#pragma unroll
      for (int u = 0; u < 2; ++u) { const hf* pr = Pg + (size_t)(tok0 + u) * PP;
#pragma unroll
        for (int m = 0; m < 6; ++m) { ga[u][m] = pr[PC_GQ + m * 64 + lane]; gb[u][m] = pr[PC_GV + m * 64 + lane]; gz[u][m] = pr[PC_GZ + m * 64 + lane]; } } }
    const int task = gwr + it * NWAVES;
    if (task < (NTOK / 16) * 6) { const int h = task % 6; const size_t tok = (size_t)(task / 6) * 16 + fr;
    h8 bg[4];
#pragma unroll
    for (int ks = 0; ks < 4; ++ks) { const h8 x = *(const h8*)(RL3 + tok * 128 + ks * 32 + fq * 8);
#pragma unroll
      for (int j = 0; j < 8; ++j) bg[ks][j] = (hf)sigmoidf_((float)x[j]); }
    f32x4 gate[4]; float y[4][4]; float ssum = 0.f, bon = 0.f; h4 vv[4];
#pragma unroll
    for (int nt = 0; nt < 4; ++nt) { f32x4 acc = {0.f, 0.f, 0.f, 0.f};
#pragma unroll
      for (int ks = 0; ks < 4; ++ks) acc = mfma16(*(const h8*)(gupT + (size_t)(h * 64 + nt * 16 + fr) * 128 + ks * 32 + fq * 8), bg[ks], acc);
      gate[nt] = acc; const int ch = h * 64 + nt * 16 + fq * 4;
      const h4 yf = *(const h4*)((const hf*)(p.ws + OFF_GV) + tok * 384 + ch), yb = h < 4 ? *(const h4*)(P + tok * PP + PC_RL2 + ch) : *(const h4*)((const hf*)(p.ws + OFF_YB2) + tok * 128 + ch - 256), rr = *(const h4*)(RL + tok * 1152 + ch), kk = *(const h4*)(RL + tok * 1152 + 384 + ch);
      const h4 af = *(const h4*)(P + tok * PP + PC_AF + ch), ab = *(const h4*)(P + tok * PP + PC_AF + 384 + ch); vv[nt] = *(const h4*)(RL + tok * 1152 + 768 + ch);
      const f32x4 ka4 = *(const f32x4*)(p.in[I_KA] + layer * 384 + ch), rk4 = *(const f32x4*)(p.in[I_RK] + layer * 384 + ch);
#pragma unroll
      for (int r = 0; r < 4; ++r) { y[nt][r] = (float)yf[r] + (float)yb[r]; ssum += y[nt][r]; const float kf = (float)kk[r];
        bon += (float)rr[r] * rk4[r] * (kf * (1.f + ((float)af[r] - 1.f) * ka4[r]) + kf * (1.f + ((float)ab[r] - 1.f) * ka4[r])); } }
    ssum += __shfl_xor(ssum, 16); ssum += __shfl_xor(ssum, 32); bon += __shfl_xor(bon, 16); bon += __shfl_xor(bon, 32);
    const float mean = ssum * (1.f / 64.f); float vs = 0.f;
#pragma unroll
    for (int nt = 0; nt < 4; ++nt)
#pragma unroll
      for (int r = 0; r < 4; ++r) { const float dl = y[nt][r] - mean; vs += dl * dl; }
    vs += __shfl_xor(vs, 16); vs += __shfl_xor(vs, 32); const float rstd = rsqrtf(vs * (1.f / 64.f) + 64e-5f);
#pragma unroll
    for (int nt = 0; nt < 4; ++nt) { const int ch = h * 64 + nt * 16 + fq * 4; const f32x4 lw = *(const f32x4*)(p.in[I_LNW] + layer * 384 + ch), lb = *(const f32x4*)(p.in[I_LNB] + layer * 384 + ch); h4 o;
#pragma unroll
      for (int r = 0; r < 4; ++r) o[r] = (hf)((((y[nt][r] - mean) * rstd) * lw[r] + lb[r] + bon * (float)vv[nt][r]) * gate[nt][r]);
      *(h4*)(Y + tok * DM + 640 + ch) = o; }
    }
    if (gv_) {
#pragma unroll
      for (int u = 0; u < 2; ++u) { float o[6], ss[6];
#pragma unroll
        for (int m = 0; m < 6; ++m) { o[m] = (float)ga[u][m] + (float)gb[u][m]; ss[m] = wave_sum(o[m] * o[m]); }
#pragma unroll
        for (int m = 0; m < 6; ++m) Y[(size_t)(tok0 + u) * DM + 256 + m * 64 + lane] = (hf)(o[m] * rsqrtf(ss[m] * (1.f / 64.f) + 1e-6f) * nwg_ * siluf_((float)gz[u][m])); } }
  }
}

__global__ void __launch_bounds__(512) mega(Params p_unused) {
  extern __shared__ __attribute__((aligned(16))) unsigned char lds_raw[];
  LAS unsigned char* lds = (LAS unsigned char*)lds_raw;
  cg::grid_group grid = cg::this_grid();
  const int wvs = __builtin_amdgcn_readfirstlane((int)__builtin_amdgcn_workitem_id_x() >> 6);
  { const Params p = load_params(); const int tid = ltid(wvs);
    if (lbid() == 0) { unsigned* bar = (unsigned*)(p.ws + OFF_BAR); for (int i = tid; i < XCD_BAR_WORDS; i += 512) bar[i] = 0u; }
    if (tid < 4) ((LAS unsigned*)(lds + LDS_ST_OFF))[tid] = 0u; }
  { const Params p = load_params(); phase0a(wvs, p, lds); }
  { const Params p = load_params(); phase_convert(wvs, p, lds, 0, 0); }
  grid.sync();
  xcd_post(wvs);
  { const Params p = load_params(); phase0b(wvs, p); phase0b_local(wvs, p); }
  gsync(wvs, lds);
#pragma unroll 1
  for (int layer = 0; layer < 2; ++layer) {
    if (layer > 0) { const Params p = load_params(); phase_convert(wvs, p, lds, layer, 0); }
    { const Params p = load_params(); phase_prenorm(wvs, p, layer, 0, layer == 0 ? p.in[I_X] : p.out, layer == 0 ? p.in[I_CTX] : (const float*)(p.ws + OFF_XCTX), layer == 1); }
    gsync(wvs, lds);
    { const Params p = load_params(); pg8::StaticOrder so; pg8::Gemm g{(const hf*)(p.ws + OFF_AY), (const hf*)(p.ws + OFF_WIN), NTOK, PP, DM, DM}; so.init(NTOK, PP, NWG, lbid()); pg8::EpiF16<0> e{}; pg8::gemm_phase(wvs, lds, g, so, e); }
    gsync(wvs, lds);
    { const Params p = load_params(); phase_x1(wvs, p, lds, layer); }
    gsync(wvs, lds);
    { const Params p = load_params(); phase_s5b(wvs, p, layer, 240); }
    { const Params p = load_params(); phase_gdb(wvs, p, lds, 240); }
    { const Params p = load_params(); phase_rwa(wvs, p, layer); }
    gsync(wvs, lds);
    { const Params p = load_params(); phase_rwb(wvs, p, lds, layer); }
    gsync(wvs, lds);
    { const Params p = load_params(); phase_gdc(wvs, p, lds, 0); }
    { const Params p = load_params(); phase_rwc(wvs, p, lds, layer, 48); }
    if (lbid() >= 240) { const Params p = load_params(); for (int cs = 0; cs < 9; ++cs) s5c_wg(wvs, p, lds, layer, (lbid() - 240) + 16 * cs); }
    gsync(wvs, lds);
    { const Params p = load_params(); if (lbid() < 136) s5d_wg(wvs, p, lds, layer, lbid()); }
    { const Params p = load_params(); phase_x5(wvs, p, layer); }
    gsync(wvs, lds);
    { const Params p = load_params(); pg8::StaticOrder so;
      pg8::Gemm g{(const hf*)(p.ws + OFF_AY), (const hf*)(p.ws + OFF_WOUT), NTOK, DM, DM, DM}; so.init(NTOK, DM, NWG, lbid(), true);
      pg8::EpiRes e{layer, 0, false}; pg8::gemm_phase(wvs, lds, g, so, e); }
    if (layer == 0) { const Params p = load_params(); pg8::StaticOrder so;
      pg8::Gemm g{(const hf*)(p.ws + OFF_AY), (const hf*)(p.ws + OFF_WOUT), NTOK, DM, 256, DM}; so.init_ctxsplit(DM, NWG, lbid(), 4, 256);
      pg8::EpiPart e{OFF_RI, 256}; pg8::gemm_phase(wvs, lds, g, so, e); }
    gsync(wvs, lds);
    { const Params p = load_params(); phase_convert(wvs, p, lds, layer, 1); }
    { const Params p = load_params(); phase_prenorm(wvs, p, layer, 1, p.out, layer == 0 ? p.in[I_CTX] : (const float*)(p.ws + OFF_XCTX), layer == 0); }
    gsync(wvs, lds);
    { const Params p = load_params(); pg8::StaticOrder so; pg8::Gemm g{(const hf*)(p.ws + OFF_AY), (const hf*)(p.ws + OFF_W1), NTOK, DFF, DM, DM}; so.init(NTOK, DFF, NWG, lbid(), layer == 1); pg8::EpiF16<1> e{}; pg8::gemm_phase(wvs, lds, g, so, e); }
    gsync(wvs, lds);
    { const Params p = load_params(); pg8::StaticOrder so;
      pg8::Gemm g{(const hf*)(p.ws + OFF_BIG), (const hf*)(p.ws + OFF_W2), NTOK, DM, DFF, DFF}; so.init(NTOK, DM, NWG, lbid(), true);
      pg8::EpiRes e{layer, 1, false}; pg8::gemm_phase(wvs, lds, g, so, e); }
    if (layer == 0) { const Params p = load_params(); pg8::StaticOrder so;
      pg8::Gemm g{(const hf*)(p.ws + OFF_BIG), (const hf*)(p.ws + OFF_W2), NTOK, DM, 1024, DFF}; so.init_ctxsplit(DM, NWG, lbid(), 4, 1024);
      pg8::EpiPart e{OFF_RI, 1024}; pg8::gemm_phase(wvs, lds, g, so, e); }
    gsync(wvs, lds);
  }
  { const Params p = load_params(); phase_final(wvs, p); }
}

extern "C" void kernel_launch(void* const* d_in, const int* in_sizes, int n_in, void* d_out, int out_size, void* d_ws, size_t ws_size, hipStream_t stream) {
  constexpr size_t kDynLds = 156 * 1024;
  static int grid_blocks = 0;
  if (!grid_blocks) {
    int dev = 0, cus = 0, per_cu = 0;
    (void)hipGetDevice(&dev);
    (void)hipDeviceGetAttribute(&cus, hipDeviceAttributeMultiprocessorCount, dev);
    (void)hipFuncSetAttribute((const void*)mega, hipFuncAttributeMaxDynamicSharedMemorySize, (int)kDynLds);
    (void)hipOccupancyMaxActiveBlocksPerMultiprocessor(&per_cu, (const void*)mega, 512, kDynLds);
    grid_blocks = NWG;
    if (cus != NWG || per_cu < 1 || ws_size < WS_NEED || n_in != 38) { fprintf(stderr, "kernel_launch: unexpected configuration: cus %d per_cu %d ws %zu n_in %d\n", cus, per_cu, ws_size, n_in); }
  }
  if (ws_size < WS_NEED || n_in != 38) return;
  Params p{};
  for (int i = 0; i < 38; ++i) p.in[i] = (const float*)d_in[i];
  p.out = (float*)d_out; p.ws = (unsigned char*)d_ws;
  void* args[] = {&p};
  hipError_t e = hipLaunchCooperativeKernel((void*)mega, dim3(grid_blocks), dim3(512), args, kDynLds, stream);
  if (e != hipSuccess) fprintf(stderr, "cooperative launch failed: %s (grid %d)\n", hipGetErrorString(e), grid_blocks);
}
```

```cpp
#include <hip/hip_runtime.h>
#include <hip/hip_cooperative_groups.h>
#include <cstdio>
namespace cg = cooperative_groups;

typedef _Float16 hf;
typedef _Float16 h8 __attribute__((ext_vector_type(8)));
typedef _Float16 h4 __attribute__((ext_vector_type(4)));
typedef _Float16 h2 __attribute__((ext_vector_type(2)));
typedef float f32x4 __attribute__((ext_vector_type(4)));
typedef float f32x2 __attribute__((ext_vector_type(2)));
#define LAS __attribute__((address_space(3)))

constexpr int NB = 4, LCTX = 256, TPB = 4352, NTOK = NB * TPB, DM = 1024, DFF = 4096;
constexpr int PP = 3584;
constexpr int NCH16 = 272, NCH64 = 68;
constexpr int NWG = 256, NWAVES = NWG * 8;
constexpr int PC_S5 = 0, PC_GQ = 256, PC_GK = 640, PC_GV = 1024, PC_GZ = 1408, PC_BETA = 1792, PC_A = 1804, PC_RW = 2048;
constexpr int PC_EF = 2048, PC_AF = 2816;

constexpr size_t SZ_WIN = (size_t)PP * DM * 2, SZ_WOUT = (size_t)DM * DM * 2, SZ_W1 = (size_t)DFF * DM * 2, SZ_W2 = SZ_W1;
constexpr size_t OFF_WIN = 0, OFF_WOUT = OFF_WIN + SZ_WIN, OFF_W1 = OFF_WOUT + SZ_WOUT, OFF_W2 = OFF_W1 + SZ_W1;
constexpr size_t SZ_GLUT = 256 * 256 * 2, SZ_WUPT = 2 * 384 * 64 * 2, SZ_GUPT = 384 * 128 * 2, SZ_SMALL = SZ_GLUT + 2 * SZ_WUPT + SZ_GUPT;
constexpr size_t OFF_SMALL = OFF_W2 + SZ_W2;
constexpr size_t SZ_S5W1 = 16 * 256 * 256 * 2, SZ_S5W2 = 16 * 256 * 512 * 2, SZ_KD = 2 * 16 * 16 * 256 * 4;
constexpr size_t OFF_S5W1 = OFF_SMALL + 2 * SZ_SMALL, OFF_S5W2 = OFF_S5W1 + 2 * SZ_S5W1, OFF_KD = OFF_S5W2 + 2 * SZ_S5W2;
constexpr size_t SZ_MODS = 2 * 5 * 6144 * 4;
constexpr size_t OFF_MODS = OFF_KD + 2 * SZ_KD;
constexpr size_t OFF_XCTX = OFF_MODS + SZ_MODS, SZ_XCTX = (size_t)NB * LCTX * DM * 4;
constexpr size_t OFF_AY = OFF_XCTX + SZ_XCTX, SZ_AY = (size_t)NTOK * DM * 2;
constexpr size_t OFF_BIG = OFF_AY + SZ_AY, SZ_H = (size_t)NTOK * DFF * 2, SZ_P = (size_t)NTOK * PP * 2;
constexpr size_t OFF_RI = OFF_BIG + SZ_P;
constexpr size_t WS_NEED = 268435456;
constexpr size_t SZ_RI = WS_NEED - OFF_RI;
static_assert(OFF_BIG + SZ_H <= WS_NEED, "H does not fit");
constexpr size_t OFF_W12 = OFF_W1, SZ_W12 = SZ_W1 + SZ_W2;
constexpr size_t SZ_GQK = (size_t)NTOK * 768 * 2, SZ_HEND = (size_t)NB * NCH16 * 16 * 256 * 2;
constexpr size_t OFF_GQK = OFF_AY, OFF_HEND = OFF_AY + SZ_GQK;
static_assert(SZ_GQK + SZ_HEND <= SZ_AY, "AY scratch");
constexpr size_t SZ_GV = (size_t)NTOK * 384 * 2, SZ_BG = (size_t)NTOK * 24 * 4;
constexpr size_t OFF_GV = OFF_W12, OFF_BG = OFF_GV + SZ_GV;
static_assert(SZ_GV + SZ_BG <= SZ_W12, "W12 scratch");
constexpr size_t SZ_RL1 = (size_t)NTOK * 1152 * 2, SZ_RL3 = (size_t)NTOK * 128 * 2, SZ_INVN = (size_t)NTOK * 6 * 4, SZ_WB = (size_t)NTOK * 384 * 2, SZ_YB2 = (size_t)NTOK * 128 * 2;
constexpr size_t OFF_RL1 = OFF_RI, OFF_RL3 = OFF_RL1 + SZ_RL1, OFF_INVN = OFF_RL3 + SZ_RL3, OFF_WB = OFF_INVN + SZ_INVN;
constexpr size_t OFF_YB2 = OFF_WB + SZ_WB;
static_assert(OFF_YB2 + SZ_YB2 <= WS_NEED - 16384, "RI scratch");
constexpr size_t RI_PART = 0, SZ_PART = 16 * SZ_MODS;
static_assert(SZ_PART <= SZ_RI, "part");
constexpr int PC_RL2 = 1792;

struct Params { const float* in[38]; float* out; unsigned char* ws; };
enum { I_X = 0, I_C, I_CTX, I_CCTX, I_MODW, I_MODB, I_NMIX, I_NMLP, I_NFIN, I_WIN, I_WOUT, I_BRE, I_BIM, I_CRE, I_CIM, I_S5D, I_ARE, I_AIM, I_LDT, I_GLUW, I_GLUB,
       I_GCONV, I_GALOG, I_GDTB, I_GNORM, I_MU, I_W0, I_WUP, I_A0, I_AUP, I_GUP, I_KK, I_KA, I_RK, I_LNW, I_LNB, I_MW1, I_MW2 };

__device__ __forceinline__ int ltid(int wvs) { int t = (wvs << 6) | (int)__builtin_amdgcn_mbcnt_hi(~0u, __builtin_amdgcn_mbcnt_lo(~0u, 0u)); asm volatile("" : "+v"(t)); return t; }
__device__ __forceinline__ int lbid() { int b = __builtin_amdgcn_workgroup_id_x(); asm volatile("" : "+s"(b)); return b; }
__device__ __forceinline__ float row16_sum(float v);
__device__ __forceinline__ float wave_sum(float v) {
  v = row16_sum(v);
  const float a = __builtin_bit_cast(float, __builtin_amdgcn_readlane(__builtin_bit_cast(int, v), 0)), b = __builtin_bit_cast(float, __builtin_amdgcn_readlane(__builtin_bit_cast(int, v), 16));
  const float c = __builtin_bit_cast(float, __builtin_amdgcn_readlane(__builtin_bit_cast(int, v), 32)), d = __builtin_bit_cast(float, __builtin_amdgcn_readlane(__builtin_bit_cast(int, v), 48));
  return (a + b) + (c + d);
}
__device__ __forceinline__ float row16_sum(float v) {
  v += __builtin_bit_cast(float, __builtin_amdgcn_update_dpp(0, __builtin_bit_cast(int, v), 0xB1, 0xF, 0xF, true));
  v += __builtin_bit_cast(float, __builtin_amdgcn_update_dpp(0, __builtin_bit_cast(int, v), 0x4E, 0xF, 0xF, true));
  v += __builtin_bit_cast(float, __builtin_amdgcn_update_dpp(0, __builtin_bit_cast(int, v), 0x141, 0xF, 0xF, true));
  v += __builtin_bit_cast(float, __builtin_amdgcn_update_dpp(0, __builtin_bit_cast(int, v), 0x140, 0xF, 0xF, true));
  return v;
}
__device__ __forceinline__ float sigmoidf_(float x) { return __builtin_amdgcn_rcpf(1.0f + __expf(-x)); }
__device__ __forceinline__ float siluf_(float x) { return x * __builtin_amdgcn_rcpf(1.0f + __expf(-x)); }
__device__ __forceinline__ float softplusf_(float x) { return x > 20.f ? x : __logf(1.0f + __expf(x)); }
__device__ __forceinline__ float tanhf_(float x) { const float e = __expf(2.0f * fminf(fmaxf(x, -15.f), 15.f)); return (e - 1.0f) * __builtin_amdgcn_rcpf(e + 1.0f); }
__device__ __forceinline__ float gelu_tanh(float x) { const float u = 0.7978845608028654f * (x + 0.044715f * x * x * x); return 0.5f * x * (1.0f + tanhf_(u)); }
__device__ __forceinline__ f32x4 mfma16(h8 a, h8 b, f32x4 c) { return __builtin_amdgcn_mfma_f32_16x16x32_f16(a, b, c, 0, 0, 0); }
__device__ __forceinline__ size_t xrow_off(int tok, bool& isctx) { const int b = tok / TPB, pos = tok - b * TPB; isctx = pos < LCTX; return isctx ? (size_t)(b * LCTX + pos) * DM : (size_t)(b * 4096 + pos - LCTX) * DM; }
__device__ __forceinline__ int mod_index(int tok) { const int b = tok / TPB, pos = tok - b * TPB; return pos < LCTX ? 4 : b; }

__device__ __forceinline__ Params load_params() {
#if defined(__HIP_DEVICE_COMPILE__)
  const __attribute__((address_space(4))) Params* kp = (const __attribute__((address_space(4))) Params*)__builtin_amdgcn_kernarg_segment_ptr(); asm volatile("" : "+s"(kp)); return *kp;
#else
  return Params{};
#endif
}

#define XB_TMO      128
#define XB_XCNT(j)  (256  + 64 * (j))
#define XB_XSUB(j)  (1280 + 64 * (j))
#define XB_XGEN(j)  (2304 + 64 * (j))
#define XB_TOP      3328
#define XB_TOPGEN   3392
#define XCD_BAR_WORDS 3456
#define XB_SPIN_CAP (1u << 22)
constexpr size_t OFF_BAR = WS_NEED - 16384;
constexpr int LDS_ST_OFF = 156 * 1024 - 16;
__device__ __forceinline__ unsigned xb_ld(unsigned* p)              { return __hip_atomic_load(p, __ATOMIC_RELAXED, __HIP_MEMORY_SCOPE_AGENT); }
__device__ __forceinline__ unsigned xb_add(unsigned* p, unsigned v) { return __hip_atomic_fetch_add(p, v, __ATOMIC_RELAXED, __HIP_MEMORY_SCOPE_AGENT); }
__device__ __forceinline__ unsigned xb_xcc_id() { return (unsigned)__builtin_amdgcn_s_getreg((3 << 11) | 20) & 0xFu; }
#define XB_SPIN(cond, bar) do { unsigned _sp = 0; while (cond) { __builtin_amdgcn_s_sleep(1); \
    if ((++_sp & 255u) == 0u) { if (xb_ld(&(bar)[XB_TMO])) break; if (_sp > XB_SPIN_CAP) { atomicAdd(&(bar)[XB_TMO], 1u); break; } } } } while (0)
__device__ __forceinline__ void xcd_post(const int wvs) {
  const Params p = load_params(); unsigned* bar = (unsigned*)(p.ws + OFF_BAR);
  if (ltid(wvs) == 0) (void)xb_add(&bar[XB_XCNT(xb_xcc_id())], 1u);
}
__device__ __forceinline__ void xcd_complete(unsigned* bar, unsigned x, unsigned& nloc, unsigned& nx) {
  const unsigned G = NWG; unsigned sum, cnt, mine, sp = 0u;
  for (;;) { sum = 0u; cnt = 0u; mine = 0u;
#pragma unroll
    for (unsigned j = 0; j < 16; ++j) { const unsigned c = xb_ld(&bar[XB_XCNT(j)]); sum += c; cnt += (c > 0u) ? 1u : 0u; mine = (j == x) ? c : mine; }
    if (sum == G) break;
    __builtin_amdgcn_s_sleep(1);
    if ((++sp & 255u) == 0u) { if (xb_ld(&bar[XB_TMO])) break; if (sp > XB_SPIN_CAP) { atomicAdd(&bar[XB_TMO], 1u); break; } } }
  nloc = mine > 0u ? mine : 1u; nx = cnt > 0u ? cnt : 1u;
}
__device__ __forceinline__ void gsync(const int wvs, LAS unsigned char* lds) {
  asm volatile("s_waitcnt vmcnt(0)" ::: "memory");
  __syncthreads();
  if (ltid(wvs) == 0) {
    const Params p = load_params(); unsigned* bar = (unsigned*)(p.ws + OFF_BAR); volatile LAS unsigned* st = (volatile LAS unsigned*)(lds + LDS_ST_OFF); const unsigned x = xb_xcc_id();
    __builtin_amdgcn_s_waitcnt(0);
    unsigned nloc = st[0], nx = st[1];
    if (nloc == 0u) { xcd_complete(bar, x, nloc, nx); st[0] = nloc; st[1] = nx; }
    const unsigned old = xb_add(&bar[XB_XSUB(x)], 1u);
    const unsigned gen = old / nloc;
    if (old + 1u == (gen + 1u) * nloc) {
      __builtin_amdgcn_fence(__ATOMIC_RELEASE, "agent");
      asm volatile("s_waitcnt vmcnt(0)" ::: "memory");
      const unsigned og = xb_add(&bar[XB_TOP], 1u);
      const unsigned tg = og / nx;
      if (og + 1u == (tg + 1u) * nx) xb_add(&bar[XB_TOPGEN], 1u);
      else XB_SPIN(xb_ld(&bar[XB_TOPGEN]) == tg, bar);
      __builtin_amdgcn_fence(__ATOMIC_ACQUIRE, "agent");
      xb_add(&bar[XB_XGEN(x)], 1u);
      asm volatile("s_waitcnt vmcnt(0)" ::: "memory");
    } else {
      XB_SPIN(xb_ld(&bar[XB_XGEN(x)]) == gen, bar);
      __builtin_amdgcn_fence(__ATOMIC_ACQUIRE, "agent");
      asm volatile("s_waitcnt vmcnt(0)" ::: "memory");
    }
  }
  __syncthreads();
}

namespace pg8 {
constexpr int BM = 256, BK = 64, HALF = 128, HTB = HALF * BK * 2, STAGE_BYTES = 8 * HTB, NXCD = 8, WGM = 8;
__host__ __device__ __forceinline__ int lds_byte(int r, int c) { const int st = (r >> 4) * 2 + (c >> 5), rr = r & 15, cc = c & 31, ob = rr * 64 + cc * 2; return st * 1024 + (ob ^ (((ob >> 9) & 1) << 5)); }
__host__ __device__ __forceinline__ void stage_rc(int b, int& R, int& C) { const int st = b / 1024, sb = b % 1024, swz = sb ^ (((sb >> 9) & 1) << 5); R = (st >> 1) * 16 + swz / 64; C = (st & 1) * 32 + (swz % 64) / 2; }
__host__ __device__ __forceinline__ int perm32(int rho) { const int n = rho >> 4, i = rho & 15; return 8 * (i >> 2) + 4 * n + (i & 3); }
struct Unit { int pm, pn, kofs; };
struct Gemm { const hf* A; const hf* Bt; int M, N, K, ld; };
struct StaticOrder {
    int nM, nN, nwg, G, c; bool latonly; int nsplit, kpart;
    __device__ void init(int M, int N, int G_, int c_, bool lo = false) { latonly = lo; nsplit = 0; kpart = 0; nM = lo ? 64 : M / BM; nN = N / BM; nwg = nM * nN; G = G_; c = c_; }
    __device__ void init_ctxsplit(int N, int G_, int c_, int nsplit_, int kpart_) { latonly = false; nsplit = nsplit_; kpart = kpart_; nM = 4; nN = N / BM; nwg = 4 * nN * nsplit_; G = G_; c = c_; }
    __device__ bool next(int i, Unit& u) const {
        const long L = (long)i * G + c; if (L >= nwg) return false;
        u.kofs = 0;
        if (nsplit > 0) { const int kp = (int)L % nsplit, cu = (int)L / nsplit; u.pm = (cu / nN) * 17; u.pn = cu % nN; u.kofs = kp * kpart; return true; }
        int wgid = (int)L; { const int q = nwg / NXCD, r = nwg % NXCD, xcd = wgid % NXCD, off = wgid / NXCD; wgid = (xcd < r ? xcd * (q + 1) : r * (q + 1) + (xcd - r) * q) + off; }
        const int nig = WGM * nN, gid = wgid / nig, fm = gid * WGM, gsz = (nM - fm) < WGM ? (nM - fm) : WGM;
        u.pm = fm + ((wgid % nig) % gsz); u.pn = (wgid % nig) / gsz; if (latonly) u.pm = (u.pm >> 4) * 17 + 1 + (u.pm & 15); return true;
    }
};
template <class Epi>
__device__ __forceinline__ void gemm_phase(const int wvs, LAS unsigned char* lds, const Gemm g, const StaticOrder& S, const Epi& E) {
    const int tid = ltid(wvs), wid = __builtin_amdgcn_readfirstlane(tid >> 6), lane = tid & 63, wr = wid >> 2, wc = wid & 3, fr = lane & 15, fq = lane >> 4;
    const int K = g.ld, nt = g.K / BK;
    unsigned voffA[2], voffB[2];
#pragma unroll
    for (int i = 0; i < 2; ++i) { int R, C; stage_rc(tid * 16 + i * 8192, R, C); const int Rb = Epi::PERM ? ((R & ~31) + perm32(R & 31)) : R;
        voffA[i] = (unsigned)(R * K + C) * 2u; voffB[i] = (unsigned)(Rb * K + C) * 2u; }
    const size_t kstep = (size_t)(BK * 2);
    const size_t hstep = (size_t)HALF * K * 2;
    const size_t tstep = 2 * hstep;
    const unsigned ldsw = (unsigned)wid * 1024u;
    const int aoff = lds_byte(wr * 64 + fr, fq * 8), boff = lds_byte(wc * 32 + fr, fq * 8);
#define PG8_SA(b, h) (((b) * 2 + (h)) * HTB)
#define PG8_SB(b, h) ((4 + (b) * 2 + (h)) * HTB)
#define PG8_STAGE(bufoff, gbase, voff) do { _Pragma("unroll") for (int _i = 0; _i < 2; ++_i) \
        __builtin_amdgcn_global_load_lds((const unsigned*)((const char*)(gbase) + (voff)[_i]), (LAS unsigned*)(lds + (bufoff) + ldsw + _i * 8192), 16, 0, 0); } while (0)
#define PG8_LDA(dst, b, h) do { _Pragma("unroll") for (int m = 0; m < 4; ++m) _Pragma("unroll") for (int k = 0; k < 2; ++k) dst[m][k] = *(const LAS h8*)(lds + PG8_SA(b, h) + aoff + m * 2048 + k * 1024); } while (0)
#define PG8_LDB(dst, b, h) do { _Pragma("unroll") for (int n = 0; n < 2; ++n) _Pragma("unroll") for (int k = 0; k < 2; ++k) dst[n][k] = *(const LAS h8*)(lds + PG8_SB(b, h) + boff + n * 2048 + k * 1024); } while (0)
#define PG8_MMA(ai, bj, At, Bt) do { __builtin_amdgcn_s_setprio(1); _Pragma("unroll") for (int m = 0; m < 4; ++m) _Pragma("unroll") for (int n = 0; n < 2; ++n) _Pragma("unroll") for (int k = 0; k < 2; ++k) \
        acc[ai][bj][m][n] = __builtin_amdgcn_mfma_f32_16x16x32_f16(Bt[n][k], At[m][k], acc[ai][bj][m][n], 0, 0, 0); __builtin_amdgcn_s_setprio(0); } while (0)
#define PG8_WAIT_V(n) asm volatile("s_waitcnt vmcnt(" #n ")" ::: "memory")
#define PG8_WAIT_L(n) asm volatile("s_waitcnt lgkmcnt(" #n ")" ::: "memory")
#define PG8_BAR __builtin_amdgcn_s_barrier()
#define PG8_SCHED __builtin_amdgcn_sched_barrier(0)
    Unit cur, nxt; int ui = 0;
    if (!S.next(0, cur)) return;
    f32x4 acc[2][2][4][2];
#pragma unroll
    for (int a = 0; a < 2; ++a)
#pragma unroll
        for (int b = 0; b < 2; ++b)
#pragma unroll
            for (int m = 0; m < 4; ++m)
#pragma unroll
                for (int n = 0; n < 2; ++n) acc[a][b][m][n] = (f32x4){0.f, 0.f, 0.f, 0.f};
    h8 At[4][2], B0[2][2], B1[2][2];
    const char* cA = (const char*)g.A + (size_t)cur.pm * tstep + (size_t)cur.kofs * 2; const char* cB = (const char*)g.Bt + (size_t)cur.pn * tstep + (size_t)cur.kofs * 2;
    PG8_STAGE(PG8_SB(0, 0), cB, voffB); PG8_STAGE(PG8_SA(0, 0), cA, voffA); PG8_STAGE(PG8_SB(0, 1), cB + hstep, voffB); PG8_STAGE(PG8_SA(0, 1), cA + hstep, voffA);
    if (wr == 1) PG8_BAR;
    PG8_WAIT_V(4); PG8_BAR;
    PG8_STAGE(PG8_SB(1, 0), cB + kstep, voffB); PG8_STAGE(PG8_SA(1, 0), cA + kstep, voffA); PG8_STAGE(PG8_SB(1, 1), cB + hstep + kstep, voffB);
    PG8_WAIT_V(6); PG8_BAR;
    for (;;) {
        const bool has_next = S.next(ui + 1, nxt);
        const char* nA = has_next ? (const char*)g.A + (size_t)nxt.pm * tstep + (size_t)nxt.kofs * 2 : cA; const char* nB = has_next ? (const char*)g.Bt + (size_t)nxt.pn * tstep + (size_t)nxt.kofs * 2 : cB;
        for (int t = 0; t < nt; t += 2) {
            const bool last = (t == nt - 2);
            const char* a1 = cA + (size_t)(t + 1) * kstep;
            const char* a2 = last ? nA : cA + (size_t)(t + 2) * kstep; const char* b2 = last ? nB : cB + (size_t)(t + 2) * kstep;
            const char* a3 = a2 + kstep; const char* b3 = b2 + kstep;
            PG8_LDB(B0, 0, 0); PG8_SCHED; PG8_LDA(At, 0, 0); PG8_STAGE(PG8_SA(1, 1), a1 + hstep, voffA);
            PG8_WAIT_L(8); PG8_BAR; PG8_WAIT_L(0); PG8_MMA(0, 0, At, B0); PG8_BAR; PG8_SCHED;
            PG8_LDB(B1, 0, 1); PG8_STAGE(PG8_SB(0, 0), b2, voffB);
            PG8_BAR; PG8_WAIT_L(0); PG8_MMA(0, 1, At, B1); PG8_BAR;
            PG8_LDA(At, 0, 1); PG8_STAGE(PG8_SA(0, 0), a2, voffA);
            PG8_BAR; PG8_WAIT_L(0); PG8_MMA(1, 0, At, B0); PG8_BAR; PG8_SCHED;
            PG8_STAGE(PG8_SB(0, 1), b2 + hstep, voffB);
            PG8_WAIT_V(6); PG8_BAR; PG8_MMA(1, 1, At, B1); PG8_BAR;
            PG8_LDB(B0, 1, 0); PG8_SCHED; PG8_LDA(At, 1, 0); PG8_STAGE(PG8_SA(0, 1), a2 + hstep, voffA);
            PG8_WAIT_L(8); PG8_BAR; PG8_WAIT_L(0); PG8_MMA(0, 0, At, B0); PG8_BAR; PG8_SCHED;
            PG8_LDB(B1, 1, 1); PG8_STAGE(PG8_SB(1, 0), b3, voffB);
            PG8_BAR; PG8_WAIT_L(0); PG8_MMA(0, 1, At, B1); PG8_BAR;
            PG8_LDA(At, 1, 1); PG8_STAGE(PG8_SA(1, 0), a3, voffA);
            PG8_BAR; PG8_WAIT_L(0); PG8_MMA(1, 0, At, B0); PG8_BAR; PG8_SCHED;
            PG8_STAGE(PG8_SB(1, 1), b3 + hstep, voffB);
            PG8_WAIT_V(6); PG8_BAR; PG8_MMA(1, 1, At, B1); PG8_BAR;
        }
        E(acc, cur, wr, wc, fr, fq);
        if (!has_next) break;
#pragma unroll
        for (int a = 0; a < 2; ++a)
#pragma unroll
            for (int b = 0; b < 2; ++b)
#pragma unroll
                for (int m = 0; m < 4; ++m)
#pragma unroll
                    for (int n = 0; n < 2; ++n) acc[a][b][m][n] = (f32x4){0.f, 0.f, 0.f, 0.f};
        cur = nxt; cA = nA; cB = nB; ++ui;
    }
    PG8_WAIT_V(0);
    if (wr == 0) PG8_BAR;
    PG8_BAR;
#undef PG8_SA
#undef PG8_SB
#undef PG8_STAGE
#undef PG8_LDA
#undef PG8_LDB
#undef PG8_MMA
#undef PG8_WAIT_V
#undef PG8_WAIT_L
#undef PG8_BAR
#undef PG8_SCHED
}
template <int ACT  > struct EpiF16 {
    static constexpr bool PERM = true;
    __device__ __forceinline__ void operator()(const f32x4 (&acc)[2][2][4][2], const Unit& u, int wr, int wc, int fr, int fq) const {
        const Params p = load_params(); hf* O = (hf*)(p.ws + OFF_BIG); constexpr int ldc = ACT == 0 ? PP : DFF;
        asm volatile("" : "+v"(fr), "+v"(fq));
        const int row0 = u.pm * BM + wr * 64 + fr, col0 = u.pn * BM + wc * 32 + 8 * fq;
#pragma unroll
        for (int ai = 0; ai < 2; ++ai)
#pragma unroll
            for (int m = 0; m < 4; ++m) { hf* rowp = O + (size_t)(row0 + ai * HALF + m * 16) * ldc + col0;
#pragma unroll
                for (int bj = 0; bj < 2; ++bj) { f32x4 v0 = acc[ai][bj][m][0], v1 = acc[ai][bj][m][1];
                    if (ACT == 1) {
#pragma unroll
                        for (int j = 0; j < 4; ++j) { const float a = fmaxf(v0[j], 0.f), b = fmaxf(v1[j], 0.f); v0[j] = a * a; v1[j] = b * b; } }
                    h8 w; w[0] = (hf)v0[0]; w[1] = (hf)v0[1]; w[2] = (hf)v0[2]; w[3] = (hf)v0[3]; w[4] = (hf)v1[0]; w[5] = (hf)v1[1]; w[6] = (hf)v1[2]; w[7] = (hf)v1[3];
                    *(h8*)(rowp + bj * HALF) = w; } }
    }
};
struct EpiPart {
    static constexpr bool PERM = false;
    size_t part_off; int kpart;
    __device__ __forceinline__ void operator()(const f32x4 (&acc)[2][2][4][2], const Unit& u, int wr, int wc, int fr, int fq) const {
        const Params p = load_params(); asm volatile("" : "+v"(fr), "+v"(fq));
        float* part = (float*)(p.ws + part_off) + (size_t)(u.kofs / kpart) * (NB * LCTX * DM) + (size_t)((u.pm / 17) * LCTX) * DM;
        const int col0 = u.pn * BM + wc * 32 + 4 * fq, rloc = wr * 64 + fr;
#pragma unroll
        for (int ai = 0; ai < 2; ++ai)
#pragma unroll
            for (int m = 0; m < 4; ++m)
#pragma unroll
                for (int bj = 0; bj < 2; ++bj)
#pragma unroll
                    for (int n = 0; n < 2; ++n) *(f32x4*)(part + (size_t)(rloc + ai * HALF + m * 16) * DM + col0 + bj * HALF + n * 16) = acc[ai][bj][m][n];
    }
};
struct EpiRes {
    static constexpr bool PERM = false;
    int layer, which; bool atomic;
    __device__ __forceinline__ void operator()(const f32x4 (&acc)[2][2][4][2], const Unit& u, int wr, int wc, int fr, int fq) const {
        const Params p = load_params(); float* ctx_out = (float*)(p.ws + OFF_XCTX); float* lat_out = p.out;
        asm volatile("" : "+v"(fr), "+v"(fq));
        const bool first = (layer == 0 && which == 0); const float* lat_in = first ? p.in[I_X] : (const float*)p.out; const float* ctx_in = first ? p.in[I_CTX] : (const float*)ctx_out;
        const float* gate = (const float*)(p.ws + OFF_MODS) + (size_t)layer * 5 * 6144 + (which == 0 ? 2 : 5) * DM;
        const int b = u.pm / 17, w = u.pm - b * 17; const bool isctx = (w == 0);
        const size_t rbase = isctx ? (size_t)(b * LCTX) * DM : (size_t)(b * 4096 + (w - 1) * 256) * DM;
        const float* xin = (isctx ? ctx_in : lat_in) + rbase; float* xout = (isctx ? ctx_out : lat_out) + rbase;
        const float* gp = gate + (size_t)(isctx ? 4 : b) * 6144;
        const int col0 = u.pn * BM + wc * 32 + 4 * fq, rloc = wr * 64 + fr;
#pragma unroll
        for (int bj = 0; bj < 2; ++bj)
#pragma unroll
            for (int n = 0; n < 2; ++n) { const f32x4 gv = *(const f32x4*)(gp + col0 + bj * HALF + n * 16);
#pragma unroll
                for (int ai = 0; ai < 2; ++ai)
#pragma unroll
                    for (int m = 0; m < 4; ++m) { const size_t ro = (size_t)(rloc + ai * HALF + m * 16) * DM + col0 + bj * HALF + n * 16;
                        if (atomic) { const f32x4 v = gv * acc[ai][bj][m][n];
#pragma unroll
                            for (int j = 0; j < 4; ++j) unsafeAtomicAdd(xout + ro + j, v[j]); }
                        else { const f32x4 xi = *(const f32x4*)(xin + ro); *(f32x4*)(xout + ro) = xi + gv * acc[ai][bj][m][n]; } }
                asm volatile("" ::: "memory"); }
    }
};
}

__device__ __forceinline__ int win_srccol(int n) { if (n < 256) return n; if (n < 2048) { const int j = n - 256; return j < 1560 ? 256 + j : -1; } return 1816 + (n - 2048); }
__device__ __forceinline__ void convert_weight(const int wvs, LAS unsigned char* lds, const float* src, hf* dst, int K, int Nsrc, int Ndst, bool wmap, int t0, int& tbase) {
  LAS float* tl = (LAS float*)lds;
  const int nkt = K / 64, nnt = Ndst / 64, ntiles = nkt * nnt, tid = ltid(wvs), ty = tid >> 6, tx = tid & 63;
  int t = t0; while (t < tbase) t += NWG;
  for (; t < tbase + ntiles; t += 4 * NWG) {
    float v[4][8];
#pragma unroll
    for (int u = 0; u < 4; ++u) { const int tu = t + u * NWG; const bool ok = tu < tbase + ntiles; const int tt = ok ? tu - tbase : 0, kt = tt % nkt, ntl = tt / nkt, k0 = kt * 64, n0 = ntl * 64;
      const int n = n0 + tx, sc = wmap ? win_srccol(n) : n;
#pragma unroll
      for (int r = 0; r < 8; ++r) { const int k = k0 + ty + 8 * r; v[u][r] = (ok && sc >= 0) ? src[(size_t)k * Nsrc + sc] : 0.f; } }
#pragma unroll
    for (int u = 0; u < 4; ++u)
#pragma unroll
      for (int r = 0; r < 8; ++r) tl[u * 4160 + (ty + 8 * r) * 65 + tx] = v[u][r];
    __syncthreads();
#pragma unroll
    for (int u = 0; u < 4; ++u) { const int tu = t + u * NWG; if (tu < tbase + ntiles) { const int tt = tu - tbase, kt = tt % nkt, ntl = tt / nkt, k0 = kt * 64, n0 = ntl * 64;
#pragma unroll
        for (int r = 0; r < 8; ++r) { const int nn = n0 + ty + 8 * r; dst[(size_t)nn * K + k0 + tx] = (hf)tl[u * 4160 + tx * 65 + ty + 8 * r]; } } }
    __syncthreads();
  }
  tbase += ntiles;
}
__device__ __forceinline__ void phase_convert(const int wvs, const Params& p, LAS unsigned char* lds, int layer, int which  ) {
  int tbase = 0; const int b = lbid();
  if (which == 0) {
    convert_weight(wvs, lds, p.in[I_WIN] + (size_t)layer * DM * 3352, (hf*)(p.ws + OFF_WIN), DM, 3352, PP, true, b, tbase);
    int t0 = b; while (t0 < tbase) t0 += NWG;
    convert_weight(wvs, lds, p.in[I_WOUT] + (size_t)layer * DM * DM, (hf*)(p.ws + OFF_WOUT), DM, DM, DM, false, t0, tbase);
  } else {
    convert_weight(wvs, lds, p.in[I_MW1] + (size_t)layer * DM * DFF, (hf*)(p.ws + OFF_W1), DM, DFF, DFF, false, b, tbase);
    int t0 = b; while (t0 < tbase) t0 += NWG;
    convert_weight(wvs, lds, p.in[I_MW2] + (size_t)layer * DFF * DM, (hf*)(p.ws + OFF_W2), DFF, DM, DM, false, t0, tbase);
  }
}

__device__ __forceinline__ void phase0a(const int wvs, const Params& p, LAS unsigned char* lds) {
  const int tid = ltid(wvs);
  { LAS float* sl = (LAS float*)lds;
    float* part = (float*)(p.ws + OFF_RI + RI_PART);
    for (int it = lbid(); it < 2 * 12 * 16; it += NWG) {
      const int ks = it % 16, jc = (it / 16) % 12, l = it / 192;
      __syncthreads();
      if (tid < 320) { const int mi = tid / 64, k = ks * 64 + (tid & 63); const float cv = mi < 4 ? p.in[I_C][mi * DM + k] : p.in[I_CCTX][k]; sl[tid] = siluf_(cv); }
      __syncthreads();
      const int j = jc * 512 + tid; float a0 = 0, a1 = 0, a2 = 0, a3 = 0, a4 = 0;
      const float* wp = p.in[I_MODW] + ((size_t)l * DM + ks * 64) * 6144 + j;
#pragma unroll 8
      for (int k = 0; k < 64; ++k) { const float w = wp[(size_t)k * 6144]; a0 += sl[k] * w; a1 += sl[64 + k] * w; a2 += sl[128 + k] * w; a3 += sl[192 + k] * w; a4 += sl[256 + k] * w; }
      float* o = part + ((size_t)(l * 16 + ks) * 5) * 6144 + j; o[0] = a0; o[6144] = a1; o[2 * 6144] = a2; o[3 * 6144] = a3; o[4 * 6144] = a4;
    }
    __syncthreads();
  }
  { LAS float* T = (LAS float*)lds;
    float* kd = (float*)(p.ws + OFF_KD);
    for (int it = lbid(); it < 2 * 2 * 16 * 16; it += NWG) {
      const int delta = it % 16, g = (it / 16) % 16, d = (it / 256) % 2, l = it / 512;
      __syncthreads();
      if (tid < 64) { const int pi = ((l * 2 + d) * 16 + g) * 64 + tid; const float ar = p.in[I_ARE][pi], ai = p.in[I_AIM][pi], dt = expf(p.in[I_LDT][(l * 2 + d) * 16 + g]);
        float s1, c1; sincosf(dt * ai, &s1, &c1); const float m1 = expf(dt * ar); const float lr = m1 * c1 - 1.f, li = m1 * s1; const float den = 1.f / (ar * ar + ai * ai);
        const float cr = (lr * ar + li * ai) * den, ci = (li * ar - lr * ai) * den;
        float sd, cd; sincosf((float)delta * dt * ai, &sd, &cd); const float md = expf((float)delta * dt * ar); const float pr = md * cd, pim = md * sd;
        T[tid * 2] = cr * pr - ci * pim; T[tid * 2 + 1] = cr * pim + ci * pr; }
      __syncthreads();
      if (tid < 256) { const int c = tid >> 4, cp = tid & 15; float s = 0.f;
        const float* cre = p.in[I_CRE] + ((size_t)(l * 16 + g) * 16 + c) * 64; const float* cim = p.in[I_CIM] + ((size_t)(l * 16 + g) * 16 + c) * 64;
        const float* bre = p.in[I_BRE] + ((size_t)(l * 16 + g) * 64) * 16 + cp; const float* bim = p.in[I_BIM] + ((size_t)(l * 16 + g) * 64) * 16 + cp;
        for (int q = 0; q < 64; ++q) { const float tr = T[q * 2], ti = T[q * 2 + 1], xr = cre[q], xi = cim[q], yr = bre[q * 16], yi = bim[q * 16];
          const float ur = xr * tr - xi * ti, ui = xr * ti + xi * tr; s += ur * yr - ui * yi; }
        kd[(((size_t)(l * 2 + d) * 16 + g) * 16 + delta) * 256 + tid] = s; }
    }
    __syncthreads();
  }
  { const int gt = lbid() * 512 + tid, gs = NWG * 512;
    for (int l = 0; l < 2; ++l) { unsigned char* sb = p.ws + OFF_SMALL + (size_t)l * SZ_SMALL;
      hf* gluT = (hf*)sb; hf* wupT = (hf*)(sb + SZ_GLUT); hf* aupT = (hf*)(sb + SZ_GLUT + SZ_WUPT); hf* gupT = (hf*)(sb + SZ_GLUT + 2 * SZ_WUPT);
      for (int i = gt; i < 65536; i += gs) { const int n = i >> 8, k = i & 255; gluT[i] = (hf)p.in[I_GLUW][(size_t)l * 65536 + k * 256 + n]; }
      for (int i = gt; i < 2 * 384 * 64; i += gs) { const int r = i & 63, n = (i >> 6) % 384, d = i / (384 * 64); const size_t si = ((size_t)(l * 2 + d) * 64 + r) * 384 + n;
        wupT[i] = (hf)p.in[I_WUP][si]; aupT[i] = (hf)p.in[I_AUP][si]; }
      for (int i = gt; i < 384 * 128; i += gs) { const int r = i & 127, n = i >> 7; gupT[i] = (hf)p.in[I_GUP][((size_t)l * 128 + r) * 384 + n]; }
    }
  }
}

__device__ __forceinline__ void phase0b(const int wvs, const Params& p) {
  const int tid = ltid(wvs), gt = lbid() * 512 + tid, gs = NWG * 512;
  { const float* part = (const float*)(p.ws + OFF_RI + RI_PART); float* mods = (float*)(p.ws + OFF_MODS);
    for (int i = gt; i < 2 * 5 * 6144; i += gs) { const int j = i % 6144, mi = (i / 6144) % 5, l = i / 30720; float s = p.in[I_MODB][l * 6144 + j];
      for (int ks = 0; ks < 16; ++ks) s += part[((size_t)(l * 16 + ks) * 5 + mi) * 6144 + j];
      mods[i] = s; } }
  for (int i = gt; i < 2 * 16 * 2 * 64 * 16; i += gs) {
    const int s = i & 15, q = (i >> 4) & 63, d = (i >> 10) & 1, g = (i >> 11) & 15, l = i >> 15;
    const int pi = ((l * 2 + d) * 16 + g) * 64 + q; const float ar = p.in[I_ARE][pi], ai = p.in[I_AIM][pi], dt = expf(p.in[I_LDT][(l * 2 + d) * 16 + g]);
    float s1, c1; sincosf(dt * ai, &s1, &c1); const float m1 = expf(dt * ar); const float lr = m1 * c1 - 1.f, li = m1 * s1; const float den = 1.f / (ar * ar + ai * ai);
    const float cr = (lr * ar + li * ai) * den, ci = (li * ar - lr * ai) * den;
    const float e = (float)(d == 0 ? 15 - s : s); float sd, cd; sincosf(e * dt * ai, &sd, &cd); const float md = expf(e * dt * ar);
    const float tr = cr * md * cd - ci * md * sd, ti = cr * md * sd + ci * md * cd;
    const float* bre = p.in[I_BRE] + ((size_t)(l * 16 + g) * 64 + q) * 16; const float* bim = p.in[I_BIM] + ((size_t)(l * 16 + g) * 64 + q) * 16;
    hf* w1 = (hf*)(p.ws + OFF_S5W1 + (size_t)l * SZ_S5W1) + ((size_t)(g * 256 + d * 128 + q * 2)) * 256 + s * 16;
    for (int c = 0; c < 16; ++c) { const float yr = bre[c], yi = bim[c]; w1[c] = (hf)(tr * yr - ti * yi); w1[256 + c] = (hf)(tr * yi + ti * yr); }
  }
  for (int i = gt; i < 2 * 16 * 2 * 64 * 16; i += gs) {
    const int j = i & 15, q = (i >> 4) & 63, d = (i >> 10) & 1, g = (i >> 11) & 15, l = i >> 15;
    const int pi = ((l * 2 + d) * 16 + g) * 64 + q; const float ar = p.in[I_ARE][pi], ai = p.in[I_AIM][pi], dt = expf(p.in[I_LDT][(l * 2 + d) * 16 + g]);
    const float e = (float)(d == 0 ? j + 1 : 16 - j); float sd, cd; sincosf(e * dt * ai, &sd, &cd); const float md = expf(e * dt * ar); const float tr = md * cd, ti = md * sd;
    hf* w2 = (hf*)(p.ws + OFF_S5W2 + (size_t)l * SZ_S5W2) + ((size_t)(g * 256 + j * 16)) * 512 + 256 + d * 128 + q * 2;
    for (int c = 0; c < 16; ++c) { const float xr = p.in[I_CRE][((size_t)(l * 16 + g) * 16 + c) * 64 + q], xi = p.in[I_CIM][((size_t)(l * 16 + g) * 16 + c) * 64 + q];
      w2[(size_t)c * 512] = (hf)(xr * tr - xi * ti); w2[(size_t)c * 512 + 1] = (hf)(-(xr * ti + xi * tr)); }
  }
}
__device__ __forceinline__ void phase0b_local(const int wvs, const Params& p) {
  const int gt = lbid() * 512 + ltid(wvs), gs = NWG * 512;
  const float* kd = (const float*)(p.ws + OFF_KD);
  for (int i = gt; i < 2 * 16 * 65536; i += gs) {
    const int k = i & 255, n = (i >> 8) & 255, g = (i >> 16) & 15, l = i >> 20; const int s = k >> 4, cp = k & 15, j = n >> 4, c = n & 15;
    float v = 0.f;
    if (s <= j) v += kd[(((size_t)(l * 2 + 0) * 16 + g) * 16 + (j - s)) * 256 + c * 16 + cp];
    if (s >= j) v += kd[(((size_t)(l * 2 + 1) * 16 + g) * 16 + (s - j)) * 256 + c * 16 + cp];
    if (s == j && c == cp) v += p.in[I_S5D][l * 256 + g * 16 + c];
    ((hf*)(p.ws + OFF_S5W2 + (size_t)l * SZ_S5W2))[((size_t)(g * 256 + n)) * 512 + k] = (hf)v;
  }
}

__device__ __forceinline__ void phase_prenorm(const int wvs, const Params& p, int layer, int which  , const float* lat, const float* ctx, bool fold) {
  const int lane = ltid(wvs) & 63, gw = lbid() * 8 + (ltid(wvs) >> 6);
  const float* gain = p.in[which == 0 ? I_NMIX : I_NMLP] + layer * DM; const float* mods = (const float*)(p.ws + OFF_MODS) + (size_t)layer * 5 * 6144;
  hf* A = (hf*)(p.ws + OFF_AY);
#pragma unroll 2
  for (int tok = gw; tok < NTOK; tok += NWAVES) {
    bool isctx; const size_t ro = xrow_off(tok, isctx); const float* xr = (isctx ? ctx : lat) + ro; const int mi = mod_index(tok);
    const float* sh = mods + (size_t)mi * 6144 + (which == 0 ? 0 : 3) * DM; const float* sc = sh + DM;
    f32x4 v[4]; float ss = 0.f;
#pragma unroll
    for (int i = 0; i < 4; ++i) v[i] = *(const f32x4*)(xr + lane * 4 + 256 * i);
    if (fold && isctx) {
      const float* gt = (const float*)(p.ws + OFF_MODS) + (size_t)4 * 6144 + (which == 1 ? 2 : 5) * DM;
      const float* part = (const float*)(p.ws + OFF_RI) + ro; float* xc = (float*)(p.ws + OFF_XCTX) + ro;
#pragma unroll
      for (int i = 0; i < 4; ++i) { const int k = lane * 4 + 256 * i; f32x4 s = *(const f32x4*)(part + k);
#pragma unroll
        for (int q = 1; q < 4; ++q) s += *(const f32x4*)(part + (size_t)q * (NB * LCTX * DM) + k);
        v[i] += *(const f32x4*)(gt + k) * s; *(f32x4*)(xc + k) = v[i]; } }
#pragma unroll
    for (int i = 0; i < 4; ++i) ss += v[i][0] * v[i][0] + v[i][1] * v[i][1] + v[i][2] * v[i][2] + v[i][3] * v[i][3];
    ss = wave_sum(ss); const float rs = rsqrtf(ss * (1.0f / DM) + 1e-6f);
#pragma unroll
    for (int i = 0; i < 4; ++i) { const int k = lane * 4 + 256 * i; const f32x4 g4 = *(const f32x4*)(gain + k), s4 = *(const f32x4*)(sc + k), h4v = *(const f32x4*)(sh + k); h4 o;
#pragma unroll
      for (int j = 0; j < 4; ++j) o[j] = (hf)((v[i][j] * rs * g4[j]) * (1.0f + s4[j]) + h4v[j]);
      *(h4*)(A + (size_t)tok * DM + k) = o; }
  }
}
__device__ __forceinline__ void phase_final(const int wvs, const Params& p) {
  const int lane = ltid(wvs) & 63, gw = lbid() * 8 + (ltid(wvs) >> 6); const float* gain = p.in[I_NFIN];
  for (int row = gw; row < NB * 4096; row += NWAVES) { float* xr = p.out + (size_t)row * DM; f32x4 v[4]; float ss = 0.f;
#pragma unroll
    for (int i = 0; i < 4; ++i) { v[i] = *(const f32x4*)(xr + lane * 4 + 256 * i); ss += v[i][0] * v[i][0] + v[i][1] * v[i][1] + v[i][2] * v[i][2] + v[i][3] * v[i][3]; }
    ss = wave_sum(ss); const float rs = rsqrtf(ss * (1.0f / DM) + 1e-6f);
#pragma unroll
    for (int i = 0; i < 4; ++i) { const int k = lane * 4 + 256 * i; const f32x4 g4 = *(const f32x4*)(gain + k); *(f32x4*)(xr + k) = v[i] * rs * g4; }
  }
}

__device__ __forceinline__ void s5a_task(const Params& p, int layer, int task, int lane) {
  const int fr = lane & 15, fq = lane >> 4;
  const hf* P = (const hf*)(p.ws + OFF_BIG); const hf* W1 = (const hf*)(p.ws + OFF_S5W1 + (size_t)layer * SZ_S5W1); hf* hend = (hf*)(p.ws + OFF_HEND);
  const int g = task & 15, cgi = task >> 4, cidx = cgi * 16 + fr, b = cidx / NCH16, n = cidx - b * NCH16; const size_t tokbase = (size_t)b * TPB + n * 16;
  f32x4 acc[16];
#pragma unroll
  for (int i = 0; i < 16; ++i) acc[i] = (f32x4){0.f, 0.f, 0.f, 0.f};
  h8 bfa[8];
#pragma unroll
  for (int ks = 0; ks < 8; ++ks) { const int s = ks * 2 + (fq >> 1), co = (fq & 1) * 8; bfa[ks] = *(const h8*)(P + (tokbase + s) * PP + PC_S5 + g * 16 + co); }
#pragma unroll 1
  for (int k2 = 0; k2 < 8; k2 += 2) { h8 a0[16], a1[16];
#pragma unroll
    for (int nt = 0; nt < 16; ++nt) { const hf* wp = W1 + ((size_t)(g * 256 + nt * 16 + fr)) * 256 + k2 * 32 + fq * 8; a0[nt] = *(const h8*)wp; a1[nt] = *(const h8*)(wp + 32); }
    const h8 b0 = (k2 == 0) ? bfa[0] : (k2 == 2) ? bfa[2] : (k2 == 4) ? bfa[4] : bfa[6], b1 = (k2 == 0) ? bfa[1] : (k2 == 2) ? bfa[3] : (k2 == 4) ? bfa[5] : bfa[7];
#pragma unroll
    for (int nt = 0; nt < 16; ++nt) { acc[nt] = mfma16(a0[nt], b0, acc[nt]); acc[nt] = mfma16(a1[nt], b1, acc[nt]); } }
#pragma unroll
  for (int nt = 0; nt < 16; ++nt) { h4 o; o[0] = (hf)acc[nt][0]; o[1] = (hf)acc[nt][1]; o[2] = (hf)acc[nt][2]; o[3] = (hf)acc[nt][3]; *(h4*)(hend + ((size_t)cidx * 16 + g) * 256 + nt * 16 + fq * 4) = o; }
}
__device__ __forceinline__ void phase_s5b(const int wvs, const Params& p, int layer, int wg0) {
  const int wgi = lbid() - wg0; if (wgi < 0 || wgi >= 16) return;
  const int gt = wgi * 512 + ltid(wvs);
  const int q = gt & 63, d = (gt >> 6) & 1, g = (gt >> 7) & 15, b = gt >> 11;
  const int pi = ((layer * 2 + d) * 16 + g) * 64 + q; const float ar = p.in[I_ARE][pi], ai = p.in[I_AIM][pi], dt = expf(p.in[I_LDT][(layer * 2 + d) * 16 + g]);
  float sd, cd; sincosf(16.f * dt * ai, &sd, &cd); const float md = expf(16.f * dt * ar); const float lr = md * cd, li = md * sd;
  hf* hend = (hf*)(p.ws + OFF_HEND);
  float hr = 0.f, hi = 0.f;
  h2 cur[16], nxt[16];
#define S5B_N(gi, j) (d == 0 ? (gi) * 16 + (j) : ((gi) == 0 ? 15 - (j) : (17 - (gi)) * 16 + 15 - (j)))
#define S5B_IX(n) (((size_t)(b * NCH16 + (n)) * 16 + g) * 256 + d * 128 + q * 2)
#pragma unroll
  for (int j = 0; j < 16; ++j) nxt[j] = *(const h2*)(hend + S5B_IX(S5B_N(0, j)));
#pragma unroll 1
  for (int gi = 0; gi < 17; ++gi) {
#pragma unroll
    for (int j = 0; j < 16; ++j) cur[j] = nxt[j];
    if (gi + 1 < 17) {
#pragma unroll
      for (int j = 0; j < 16; ++j) nxt[j] = *(const h2*)(hend + S5B_IX(S5B_N(gi + 1, j))); }
#pragma unroll
    for (int j = 0; j < 16; ++j) { h2 o; o[0] = (hf)hr; o[1] = (hf)hi; *(h2*)(hend + S5B_IX(S5B_N(gi, j))) = o;
      const float nr = lr * hr - li * hi + (float)cur[j][0], ni = lr * hi + li * hr + (float)cur[j][1]; hr = nr; hi = ni; }
  }
#undef S5B_N
#undef S5B_IX
}
__device__ __forceinline__ void s5c_task(const Params& p, int layer, int task, int lane) {
  const int fr = lane & 15, fq = lane >> 4;
  hf* P = (hf*)(p.ws + OFF_BIG); const hf* W2 = (const hf*)(p.ws + OFF_S5W2 + (size_t)layer * SZ_S5W2); const hf* hin = (const hf*)(p.ws + OFF_HEND);
  const int g = task & 15, cgi = task >> 4, cidx = cgi * 16 + fr, b = cidx / NCH16, n = cidx - b * NCH16; const size_t tokbase = (size_t)b * TPB + n * 16;
  f32x4 acc[16];
#pragma unroll
  for (int i = 0; i < 16; ++i) acc[i] = (f32x4){0.f, 0.f, 0.f, 0.f};
#pragma unroll 1
  for (int k2 = 0; k2 < 16; k2 += 2) { h8 a0[16], a1[16], b0, b1;
    if (k2 < 8) { const int s = k2 * 2 + (fq >> 1), co = (fq & 1) * 8; b0 = *(const h8*)(P + (tokbase + s) * PP + PC_S5 + g * 16 + co); b1 = *(const h8*)(P + (tokbase + s + 2) * PP + PC_S5 + g * 16 + co); }
    else { const hf* hp = hin + ((size_t)cidx * 16 + g) * 256 + (k2 - 8) * 32 + fq * 8; b0 = *(const h8*)hp; b1 = *(const h8*)(hp + 32); }
#pragma unroll
    for (int nt = 0; nt < 16; ++nt) { const hf* wp = W2 + ((size_t)(g * 256 + nt * 16 + fr)) * 512 + k2 * 32 + fq * 8; a0[nt] = *(const h8*)wp; a1[nt] = *(const h8*)(wp + 32); }
#pragma unroll
    for (int nt = 0; nt < 16; ++nt) { acc[nt] = mfma16(a0[nt], b0, acc[nt]); acc[nt] = mfma16(a1[nt], b1, acc[nt]); } }
  h4 o[16];
#pragma unroll
  for (int nt = 0; nt < 16; ++nt) {
#pragma unroll
    for (int r = 0; r < 4; ++r) o[nt][r] = (hf)gelu_tanh(acc[nt][r]); }
  __builtin_amdgcn_wave_barrier();
#pragma unroll
  for (int nt = 0; nt < 16; ++nt) *(h4*)(P + (tokbase + nt) * PP + PC_S5 + g * 16 + fq * 4) = o[nt];
}
__device__ __forceinline__ void s5d_task(const Params& p, int layer, int task, int lane) {
  const int fr = lane & 15, fq = lane >> 4;
  const hf* P = (const hf*)(p.ws + OFF_BIG); const hf* gluT = (const hf*)(p.ws + OFF_SMALL + (size_t)layer * SZ_SMALL); hf* Y = (hf*)(p.ws + OFF_AY);
  const float* gb = p.in[I_GLUB] + layer * 256;
  const size_t tok = (size_t)task * 16 + fr;
  f32x4 acc[16];
#pragma unroll
  for (int i = 0; i < 16; ++i) acc[i] = (f32x4){0.f, 0.f, 0.f, 0.f};
#pragma unroll 1
  for (int k2 = 0; k2 < 8; k2 += 2) { h8 a0[16], a1[16]; const h8 b0 = *(const h8*)(P + tok * PP + PC_S5 + k2 * 32 + fq * 8), b1 = *(const h8*)(P + tok * PP + PC_S5 + k2 * 32 + 32 + fq * 8);
#pragma unroll
    for (int nt = 0; nt < 16; ++nt) { const hf* wp = gluT + (size_t)(nt * 16 + fr) * 256 + k2 * 32 + fq * 8; a0[nt] = *(const h8*)wp; a1[nt] = *(const h8*)(wp + 32); }
#pragma unroll
    for (int nt = 0; nt < 16; ++nt) { acc[nt] = mfma16(a0[nt], b0, acc[nt]); acc[nt] = mfma16(a1[nt], b1, acc[nt]); } }
#pragma unroll
  for (int nt = 0; nt < 16; ++nt) { const int n4 = nt * 16 + fq * 4; const h4 zz = *(const h4*)(P + tok * PP + PC_S5 + n4); const f32x4 b4 = *(const f32x4*)(gb + n4); h4 o;
#pragma unroll
    for (int r = 0; r < 4; ++r) o[r] = (hf)((float)zz[r] * sigmoidf_(acc[nt][r] + b4[r]));
    *(h4*)(Y + tok * DM + n4) = o; }
}

template <int NK32>
__device__ __forceinline__ void wg_gemm256(LAS unsigned char* lds, const hf* W, const int ldw, const h8 (&bf)[NK32], f32x4 (&acc)[16], const int tid, const int fr, const int fq) {
  constexpr int NS = NK32 / 4; h8 st[8];
#pragma unroll
  for (int j = 0; j < 8; ++j) { const int idx = tid + 512 * j; st[j] = *(const h8*)(W + (size_t)(idx >> 4) * ldw + (idx & 15) * 8); }
#pragma unroll
  for (int s = 0; s < NS; ++s) {
    __syncthreads();
#pragma unroll
    for (int j = 0; j < 8; ++j) { const int idx = tid + 512 * j; *(LAS h8*)(lds + (idx >> 4) * 272 + (idx & 15) * 16) = st[j]; }
    if (s + 1 < NS) {
#pragma unroll
      for (int j = 0; j < 8; ++j) { const int idx = tid + 512 * j; st[j] = *(const h8*)(W + (size_t)(idx >> 4) * ldw + (s + 1) * 128 + (idx & 15) * 8); } }
    __syncthreads();
#pragma unroll
    for (int ks = 0; ks < 4; ++ks)
#pragma unroll
      for (int nt = 0; nt < 16; ++nt) acc[nt] = mfma16(*(const LAS h8*)(lds + (nt * 16 + fr) * 272 + ks * 64 + fq * 16), bf[s * 4 + ks], acc[nt]);
  }
}
__device__ __forceinline__ void s5a_wg(const int wvs, const Params& p, LAS unsigned char* lds, int layer, int task) {
  const int tid = ltid(wvs), wv = tid >> 6, lane = tid & 63, fr = lane & 15, fq = lane >> 4;
  const hf* P = (const hf*)(p.ws + OFF_BIG); const hf* W1 = (const hf*)(p.ws + OFF_S5W1 + (size_t)layer * SZ_S5W1); hf* hend = (hf*)(p.ws + OFF_HEND);
  const int g = task & 15, cgi = (task >> 4) * 8 + wv; const bool valid = cgi < 68; const int cidx = (valid ? cgi : 0) * 16 + fr, b = cidx / NCH16, n = cidx - b * NCH16; const size_t tokbase = (size_t)b * TPB + n * 16;
  h8 bf[8]; f32x4 acc[16];
#pragma unroll
  for (int i = 0; i < 16; ++i) acc[i] = (f32x4){0.f, 0.f, 0.f, 0.f};
#pragma unroll
  for (int ks = 0; ks < 8; ++ks) { const int s = ks * 2 + (fq >> 1), co = (fq & 1) * 8; bf[ks] = *(const h8*)(P + (tokbase + s) * PP + PC_S5 + g * 16 + co); }
  wg_gemm256<8>(lds, W1 + (size_t)g * 256 * 256, 256, bf, acc, tid, fr, fq);
  if (valid) {
#pragma unroll
    for (int nt = 0; nt < 16; ++nt) { h4 o; o[0] = (hf)acc[nt][0]; o[1] = (hf)acc[nt][1]; o[2] = (hf)acc[nt][2]; o[3] = (hf)acc[nt][3]; *(h4*)(hend + ((size_t)cidx * 16 + g) * 256 + nt * 16 + fq * 4) = o; } }
}
__device__ __forceinline__ void s5c_wg(const int wvs, const Params& p, LAS unsigned char* lds, int layer, int task) {
  const int tid = ltid(wvs), wv = tid >> 6, lane = tid & 63, fr = lane & 15, fq = lane >> 4;
  hf* P = (hf*)(p.ws + OFF_BIG); const hf* W2 = (const hf*)(p.ws + OFF_S5W2 + (size_t)layer * SZ_S5W2); const hf* hin = (const hf*)(p.ws + OFF_HEND);
  const int g = task & 15, cgi = (task >> 4) * 8 + wv; const bool valid = cgi < 68; const int cidx = (valid ? cgi : 0) * 16 + fr, b = cidx / NCH16, n = cidx - b * NCH16; const size_t tokbase = (size_t)b * TPB + n * 16;
  h8 bf[16]; f32x4 acc[16];
#pragma unroll
  for (int i = 0; i < 16; ++i) acc[i] = (f32x4){0.f, 0.f, 0.f, 0.f};
#pragma unroll
  for (int ks = 0; ks < 8; ++ks) { const int s = ks * 2 + (fq >> 1), co = (fq & 1) * 8; bf[ks] = *(const h8*)(P + (tokbase + s) * PP + PC_S5 + g * 16 + co);
    bf[8 + ks] = *(const h8*)(hin + ((size_t)cidx * 16 + g) * 256 + ks * 32 + fq * 8); }
  wg_gemm256<16>(lds, W2 + (size_t)g * 256 * 512, 512, bf, acc, tid, fr, fq);
  if (valid) {
#pragma unroll
    for (int nt = 0; nt < 16; ++nt) { h4 o;
#pragma unroll
      for (int r = 0; r < 4; ++r) o[r] = (hf)gelu_tanh(acc[nt][r]);
      *(h4*)(P + (tokbase + nt) * PP + PC_S5 + g * 16 + fq * 4) = o; } }
}
__device__ __forceinline__ void s5d_wg(const int wvs, const Params& p, LAS unsigned char* lds, int layer, int task) {
  const int tid = ltid(wvs), wv = tid >> 6, lane = tid & 63, fr = lane & 15, fq = lane >> 4;
  const hf* P = (const hf*)(p.ws + OFF_BIG); const hf* gluT = (const hf*)(p.ws + OFF_SMALL + (size_t)layer * SZ_SMALL); hf* Y = (hf*)(p.ws + OFF_AY);
  const float* gb = p.in[I_GLUB] + layer * 256;
  const size_t tok = (size_t)task * 128 + wv * 16 + fr;
  h8 bf[8]; f32x4 acc[16];
#pragma unroll
  for (int i = 0; i < 16; ++i) acc[i] = (f32x4){0.f, 0.f, 0.f, 0.f};
#pragma unroll
  for (int ks = 0; ks < 8; ++ks) bf[ks] = *(const h8*)(P + tok * PP + PC_S5 + ks * 32 + fq * 8);
  wg_gemm256<8>(lds, gluT, 256, bf, acc, tid, fr, fq);
#pragma unroll
  for (int nt = 0; nt < 16; ++nt) { const int n4 = nt * 16 + fq * 4; const h4 zz = *(const h4*)(P + tok * PP + PC_S5 + n4); const f32x4 b4 = *(const f32x4*)(gb + n4); h4 o;
#pragma unroll
    for (int r = 0; r < 4; ++r) o[r] = (hf)((float)zz[r] * sigmoidf_(acc[nt][r] + b4[r]));
    *(h4*)(Y + tok * DM + n4) = o; }
}

__device__ __forceinline__ void gda_task(const Params& p, int layer, int task, int lane) {
  const hf* P = (const hf*)(p.ws + OFF_BIG); hf* GQK = (hf*)(p.ws + OFF_GQK); hf* GV = (hf*)(p.ws + OFF_GV); float* BG = (float*)(p.ws + OFF_BG);
  const float* cw = p.in[I_GCONV] + (size_t)layer * 5 * 1152;
  const int h = task % 6, n = (task / 6) % NCH64, b = task / (6 * NCH64); const int pos0 = n * 64, seg_lo = n < 4 ? 0 : LCTX, seg_hi = n < 4 ? LCTX : TPB;
  float w[3][5], win[3][5];
#pragma unroll
  for (int s = 0; s < 3; ++s)
#pragma unroll
    for (int j = 0; j < 5; ++j) w[s][j] = cw[j * 1152 + s * 384 + h * 64 + lane];
  const size_t tb = (size_t)b * TPB;
#pragma unroll
  for (int j = 0; j < 4; ++j) { const int ps = pos0 - 2 + j; const bool ok = ps >= seg_lo && ps < seg_hi;
#pragma unroll
    for (int s = 0; s < 3; ++s) win[s][j + 1] = ok ? (float)P[(tb + ps) * PP + PC_GQ + s * 384 + h * 64 + lane] : 0.f; }
  hf ring[8][3];
#pragma unroll
  for (int u = 0; u < 8; ++u) { const int ps = pos0 + u + 2; const bool ok = ps < seg_hi;
#pragma unroll
    for (int s = 0; s < 3; ++s) ring[u][s] = ok ? P[(tb + ps) * PP + PC_GQ + s * 384 + h * 64 + lane] : (hf)0.f; }
#pragma unroll 1
  for (int i0 = 0; i0 < 64; i0 += 8) {
    hf cur[8][3];
#pragma unroll
    for (int u = 0; u < 8; ++u)
#pragma unroll
      for (int s = 0; s < 3; ++s) cur[u][s] = ring[u][s];
    if (i0 + 8 < 64) {
#pragma unroll
      for (int u = 0; u < 8; ++u) { const int ps = pos0 + i0 + 8 + u + 2; const bool ok = ps < seg_hi;
#pragma unroll
        for (int s = 0; s < 3; ++s) ring[u][s] = ok ? P[(tb + ps) * PP + PC_GQ + s * 384 + h * 64 + lane] : (hf)0.f; } }
#pragma unroll
    for (int u = 0; u < 8; ++u) { const int pos = pos0 + i0 + u; float o[3];
#pragma unroll
      for (int s = 0; s < 3; ++s) { win[s][0] = win[s][1]; win[s][1] = win[s][2]; win[s][2] = win[s][3]; win[s][3] = win[s][4]; win[s][4] = (float)cur[u][s];
        float a = 0.f;
#pragma unroll
        for (int j = 0; j < 5; ++j) a += w[s][j] * win[s][j];
        o[s] = siluf_(a); }
      const float sq = wave_sum(o[0] * o[0]), sk = wave_sum(o[1] * o[1]);
      o[0] *= rsqrtf(sq + 1e-6f) * 0.125f; o[1] *= rsqrtf(sk + 1e-6f);
      hf* dst = GQK + (tb + pos) * 768 + h * 64 + lane; dst[0] = (hf)o[0]; dst[384] = (hf)o[1]; GV[(tb + pos) * 384 + h * 64 + lane] = (hf)o[2]; } }
  if (h == 0) { const size_t tok = tb + pos0 + lane;
    for (int j = 0; j < 12; ++j) { BG[tok * 24 + j] = sigmoidf_((float)P[tok * PP + PC_BETA + j]);
      BG[tok * 24 + 12 + j] = -expf(p.in[I_GALOG][layer * 12 + j]) * softplusf_((float)P[tok * PP + PC_A + j] + p.in[I_GDTB][layer * 12 + j]); } }
}
__device__ __forceinline__ void phase_x1(const int wvs, const Params& p, LAS unsigned char* lds, int layer) {
  const int bid = lbid();
  if (bid < 52) { for (int task = bid; task < 144; task += 52) s5a_wg(wvs, p, lds, layer, task); }
  else { const int lane = ltid(wvs) & 63; gda_task(p, layer, (bid - 52) * 8 + (ltid(wvs) >> 6), lane); }
}
__device__ __forceinline__ void phase_gdb(const int wvs, const Params& p, LAS unsigned char* lds, int nwg) {
  constexpr int RP = 136, SLOT = 16384 + 64 * RP * 2 + 768;
  const int tid = ltid(wvs), tq = tid >> 7, t = tid & 127, lane = tid & 63, w2 = (tid >> 6) & 1, fr = lane & 15, fq = lane >> 4;
  LAS float* M = (LAS float*)(lds + tq * SLOT); LAS hf* R = (LAS hf*)(lds + tq * SLOT + 16384); LAS float* gs = (LAS float*)(lds + tq * SLOT + 16384 + 64 * RP * 2); LAS float* bs = gs + 64; LAS float* gcs = bs + 64;
  hf* P = (hf*)(p.ws + OFF_BIG); const hf* GQK = (const hf*)(p.ws + OFF_GQK); const hf* GV = (const hf*)(p.ws + OFF_GV); const float* BG = (const float*)(p.ws + OFF_BG); hf* WB = (hf*)(p.ws + OFF_WB);
  const int rr = t >> 4, cc = (t & 15) * 8;
  if (lbid() >= nwg) return;
  for (int grp = lbid(); grp < NB * NCH64 * 12 / 4; grp += nwg) {
    const int task = grp * 4 + tq, d = task & 1, h = (task >> 1) % 6, n = (task / 12) % NCH64, b = task / (12 * NCH64);
    const size_t tokbase = (size_t)b * TPB + n * 64;
#define TOKI(i) (tokbase + (d ? 63 - (i) : (i)))
    if (t < 64) { gs[t] = BG[TOKI(t) * 24 + 12 + d * 6 + h]; bs[t] = BG[TOKI(t) * 24 + d * 6 + h]; }
    { h8 rv[8];
#pragma unroll
      for (int ps = 0; ps < 8; ++ps) { const int i = ps * 8 + rr; const hf* srcp = cc < 64 ? GV + TOKI(i) * 384 + h * 64 + cc : GQK + TOKI(i) * 768 + 384 + h * 64 + cc - 64; rv[ps] = *(const h8*)srcp; }
#pragma unroll
      for (int ps = 0; ps < 8; ++ps) *(LAS h8*)(R + (ps * 8 + rr) * RP + cc) = rv[ps]; }
    __syncthreads();
    if (t < 64) { float s = gs[t];
#define GD_DPP(ctrl, rmask) s += __builtin_bit_cast(float, __builtin_amdgcn_update_dpp(0, __builtin_bit_cast(int, s), ctrl, rmask, 0xF, true))
      GD_DPP(0x111, 0xF); GD_DPP(0x112, 0xF); GD_DPP(0x114, 0xF); GD_DPP(0x118, 0xF); GD_DPP(0x142, 0xA); GD_DPP(0x143, 0xC);
#undef GD_DPP
      gcs[t] = s; ((float*)(p.ws + OFF_BG))[TOKI(t) * 24 + 12 + d * 6 + h] = s; }
    __syncthreads();
#pragma unroll 1
    for (int tl = w2 * 5; tl < w2 * 5 + 5; ++tl) { const int ti = tl < 1 ? 0 : tl < 3 ? 1 : tl < 6 ? 2 : 3, tj = tl - (ti * (ti + 1)) / 2;
      f32x4 acc = {0.f, 0.f, 0.f, 0.f};
#pragma unroll
      for (int ks = 0; ks < 2; ++ks) { const h8 af = *(const LAS h8*)(R + (ti * 16 + fr) * RP + 64 + ks * 32 + fq * 8); const h8 bf = *(const LAS h8*)(R + (tj * 16 + fr) * RP + 64 + ks * 32 + fq * 8);
        acc = mfma16(af, bf, acc); }
#pragma unroll
      for (int r = 0; r < 4; ++r) { const int i = ti * 16 + fq * 4 + r, j = tj * 16 + fr; M[i * 64 + j] = (j < i) ? bs[i] * acc[r] * __expf(gcs[i] - gcs[j]) : 0.f; } }
    __syncthreads();
    { float x[64]; const bool isw = t >= 64;
#pragma unroll
      for (int i = 0; i < 64; ++i) { const float v = (float)R[i * RP + t]; x[i] = v * bs[i] * (isw ? __expf(gcs[i]) : 1.0f); asm volatile("" : "+v"(x[i])); if ((i & 7) == 7) __builtin_amdgcn_sched_barrier(0); }
#pragma unroll
      for (int i = 1; i < 64; ++i) {
#pragma unroll
        for (int j4 = 0; j4 < (i + 3) / 4; ++j4) { const f32x4 m4 = *(const LAS f32x4*)(M + i * 64 + j4 * 4);
#pragma unroll
          for (int jj = 0; jj < 4; ++jj) if (j4 * 4 + jj < i) x[i] -= m4[jj] * x[j4 * 4 + jj]; }
        __builtin_amdgcn_sched_barrier(0); }
#pragma unroll
      for (int i = 0; i < 64; ++i) R[i * RP + t] = (hf)x[i]; }
    __syncthreads();
#undef TOKI
    { int tid2 = tid; asm volatile("" : "+v"(tid2));
      const int tq2 = tid2 >> 7, t2 = tid2 & 127, rr2 = t2 >> 4, cc2 = (t2 & 15) * 8; LAS hf* R2 = (LAS hf*)(lds + tq2 * SLOT + 16384);
      const int task2 = grp * 4 + tq2, d2 = task2 & 1, h2 = (task2 >> 1) % 6, n2 = (task2 / 12) % NCH64, b2 = task2 / (12 * NCH64); const size_t tokbase2 = (size_t)b2 * TPB + n2 * 64;
#pragma unroll 1
      for (int ps = 0; ps < 8; ++ps) { const int i = ps * 8 + rr2; const h8 v = *(const LAS h8*)(R2 + i * RP + cc2); const size_t tk = tokbase2 + (d2 ? 63 - i : i);
        hf* dst = cc2 < 64 ? P + tk * PP + (d2 ? PC_GV : PC_GQ) + h2 * 64 + cc2 : (d2 == 0 ? P + tk * PP + PC_GK + h2 * 64 + cc2 - 64 : WB + tk * 384 + h2 * 64 + cc2 - 64);
        *(h8*)dst = v; } }
    __syncthreads();
  }
}
__device__ __forceinline__ void phase_gdc(const int wvs, const Params& p, LAS unsigned char* lds, int wg0) {
  const int wgi = lbid() - wg0; if (wgi < 0 || wgi >= NB * 12) return;
  constexpr int LP = 72, ARR = 64 * LP;
  const int tid = ltid(wvs), wv = tid >> 6, lane = tid & 63, fr = lane & 15, fq = lane >> 4;
  const int d = wgi / 24, bh = wgi - d * 24, h = bh % 6, b = bh / 6;
  LAS hf* QKb = (LAS hf*)lds;
  LAS hf* VnT = QKb + 6 * ARR; LAS hf* At = VnT + ARR; LAS hf* ST0 = At + ARR; LAS hf* ST1 = ST0 + ARR;
  LAS float* gcb = (LAS float*)(ST1 + ARR);
  hf* P = (hf*)(p.ws + OFF_BIG); const hf* GQK = (const hf*)(p.ws + OFF_GQK); const float* BG = (const float*)(p.ws + OFF_BG); const hf* WB = (const hf*)(p.ws + OFF_WB);
  const int ucol = (d ? PC_GV : PC_GQ) + h * 64;
  const int ti = wv >> 1, tv0 = (wv & 1) * 2;
  const int li = tid >> 3, k8 = (tid & 7) * 8;
  f32x4 Sacc[2] = {{0.f, 0.f, 0.f, 0.f}, {0.f, 0.f, 0.f, 0.f}};
  for (int i = tid; i < ARR; i += 512) { ST0[i] = (hf)0.f; ST1[i] = (hf)0.f; }
  h8 pq, pk, pwa[2]; float pgi, pgl, pg; hf pu[2][4];
#define GD_CHUNK(cn) (d == 0 ? (cn) : ((cn) < 4 ? 3 - (cn) : 71 - (cn)))
#define GD_PREFETCH(cn) { const size_t tb_ = (size_t)b * TPB + GD_CHUNK(cn) * 64; const int gcol = 12 + d * 6 + h; \
    { const size_t tk = tb_ + (d ? 63 - li : li); pq = *(const h8*)(GQK + tk * 768 + h * 64 + k8); pk = *(const h8*)(GQK + tk * 768 + 384 + h * 64 + k8); pgi = BG[tk * 24 + gcol]; } \
    pgl = BG[(tb_ + (d ? 0 : 63)) * 24 + gcol]; pg = BG[(tb_ + (d ? 63 - (tid & 63) : (tid & 63))) * 24 + gcol]; \
    { const size_t tk = tb_ + (d ? 63 - (ti * 16 + fr) : (ti * 16 + fr)); _Pragma("unroll") for (int ks = 0; ks < 2; ++ks) \
        pwa[ks] = d == 0 ? *(const h8*)(P + tk * PP + PC_GK + h * 64 + ks * 32 + fq * 8) : *(const h8*)(WB + tk * 384 + h * 64 + ks * 32 + fq * 8); } \
    _Pragma("unroll") for (int t2 = 0; t2 < 2; ++t2) _Pragma("unroll") for (int r = 0; r < 4; ++r) { const int i_ = ti * 16 + fq * 4 + r; pu[t2][r] = P[(tb_ + (d ? 63 - i_ : i_)) * PP + ucol + (tv0 + t2) * 16 + fr]; } }
  GD_PREFETCH(0)
#pragma unroll 1
  for (int cn = 0; cn < NCH64; ++cn) {
    const size_t tokbase = (size_t)b * TPB + GD_CHUNK(cn) * 64;
    LAS hf* Qs = QKb + (cn & 1) * 3 * ARR; LAS hf* Ks = Qs + ARR; LAS hf* KdT = Ks + ARR; LAS float* gcm = gcb + (cn & 1) * 64;
    LAS hf* STr = (cn & 1) ? ST1 : ST0; LAS hf* STw = (cn & 1) ? ST0 : ST1;
#define TOKI(i) (tokbase + (d ? 63 - (i) : (i)))
    const float glast = pgl;
    if (tid < 64) gcm[tid] = pg;
    { *(LAS h8*)(Qs + li * LP + k8) = pq; *(LAS h8*)(Ks + li * LP + k8) = pk; const float sc = __expf(glast - pgi);
#pragma unroll
      for (int j = 0; j < 8; ++j) KdT[(k8 + j) * LP + li] = (hf)((float)pk[j] * sc); }
    h8 wa[2] = {pwa[0], pwa[1]}; hf cu[2][4];
#pragma unroll
    for (int t2 = 0; t2 < 2; ++t2)
#pragma unroll
      for (int r = 0; r < 4; ++r) cu[t2][r] = pu[t2][r];
    __syncthreads();
    if (cn + 1 < NCH64) GD_PREFETCH(cn + 1)
#pragma unroll
    for (int t2 = 0; t2 < 2; ++t2) { const int tv = tv0 + t2; f32x4 acc = {0.f, 0.f, 0.f, 0.f};
#pragma unroll
      for (int ks = 0; ks < 2; ++ks) { const h8 bf = *(const LAS h8*)(STr + (tv * 16 + fr) * LP + ks * 32 + fq * 8); acc = mfma16(wa[ks], bf, acc); }
      h4 o;
#pragma unroll
      for (int r = 0; r < 4; ++r) o[r] = (hf)((float)cu[t2][r] - acc[r]);
      *(LAS h4*)(VnT + (tv * 16 + fr) * LP + ti * 16 + fq * 4) = o; }
#pragma unroll
    for (int t2 = 0; t2 < 2; ++t2) { const int tj = tv0 + t2; h4 o = {(hf)0.f, (hf)0.f, (hf)0.f, (hf)0.f};
      if (tj <= ti) { f32x4 acc = {0.f, 0.f, 0.f, 0.f};
#pragma unroll
        for (int ks = 0; ks < 2; ++ks) { const h8 af = *(const LAS h8*)(Ks + (tj * 16 + fr) * LP + ks * 32 + fq * 8); const h8 bf = *(const LAS h8*)(Qs + (ti * 16 + fr) * LP + ks * 32 + fq * 8); acc = mfma16(af, bf, acc); }
        const int i = ti * 16 + fr; const float gi = gcm[i];
#pragma unroll
        for (int r = 0; r < 4; ++r) { const int j = tj * 16 + fq * 4 + r; o[r] = (hf)((j <= i) ? acc[r] * __expf(gi - gcm[j]) : 0.f); } }
      *(LAS h4*)(At + (ti * 16 + fr) * LP + tj * 16 + fq * 4) = o; }
    __syncthreads();
#pragma unroll
    for (int t2 = 0; t2 < 2; ++t2) { const int tv = tv0 + t2; f32x4 a1 = {0.f, 0.f, 0.f, 0.f}, a2 = {0.f, 0.f, 0.f, 0.f};
#pragma unroll
      for (int ks = 0; ks < 2; ++ks) { const h8 bq = *(const LAS h8*)(Qs + (ti * 16 + fr) * LP + ks * 32 + fq * 8); const h8 as = *(const LAS h8*)(STr + (tv * 16 + fr) * LP + ks * 32 + fq * 8); a1 = mfma16(as, bq, a1);
        const h8 ba = *(const LAS h8*)(At + (ti * 16 + fr) * LP + ks * 32 + fq * 8); const h8 av = *(const LAS h8*)(VnT + (tv * 16 + fr) * LP + ks * 32 + fq * 8); a2 = mfma16(av, ba, a2); }
      const int i = ti * 16 + fr; const float eg = __expf(gcm[i]); h4 o;
#pragma unroll
      for (int r = 0; r < 4; ++r) o[r] = (hf)(eg * a1[r] + a2[r]);
      *(h4*)(P + TOKI(i) * PP + ucol + tv * 16 + fq * 4) = o; }
    { const float egl = __expf(glast); const int tk = ti;
#pragma unroll
      for (int t2 = 0; t2 < 2; ++t2) { const int tv = tv0 + t2; f32x4 acc = Sacc[t2] * egl;
#pragma unroll
        for (int ks = 0; ks < 2; ++ks) { const h8 af = *(const LAS h8*)(KdT + (tk * 16 + fr) * LP + ks * 32 + fq * 8); const h8 bf = *(const LAS h8*)(VnT + (tv * 16 + fr) * LP + ks * 32 + fq * 8); acc = mfma16(af, bf, acc); }
        Sacc[t2] = acc; h4 o;
#pragma unroll
        for (int r = 0; r < 4; ++r) o[r] = (hf)acc[r];
        *(LAS h4*)(STw + (tv * 16 + fr) * LP + tk * 16 + fq * 4) = o; } }
#undef TOKI
  }
#undef GD_PREFETCH
#undef GD_CHUNK
}
__device__ __forceinline__ void phase_gdd(const int wvs, const Params& p, int layer) {
  const int lane = ltid(wvs) & 63, gw = lbid() * 8 + (ltid(wvs) >> 6);
  const hf* P = (const hf*)(p.ws + OFF_BIG); hf* Y = (hf*)(p.ws + OFF_AY); const float nw = p.in[I_GNORM][layer * 64 + lane];
  for (int tok0 = gw * 2; tok0 < NTOK; tok0 += NWAVES * 2) {
    hf a[2][6], bq[2][6], zz[2][6];
#pragma unroll
    for (int u = 0; u < 2; ++u) { const hf* pr = P + (size_t)(tok0 + u) * PP;
#pragma unroll
      for (int m = 0; m < 6; ++m) { a[u][m] = pr[PC_GQ + m * 64 + lane]; bq[u][m] = pr[PC_GV + m * 64 + lane]; zz[u][m] = pr[PC_GZ + m * 64 + lane]; } }
#pragma unroll
    for (int u = 0; u < 2; ++u) { float o[6], ss[6];
#pragma unroll
      for (int m = 0; m < 6; ++m) { o[m] = (float)a[u][m] + (float)bq[u][m]; ss[m] = wave_sum(o[m] * o[m]); }
#pragma unroll
      for (int m = 0; m < 6; ++m) Y[(size_t)(tok0 + u) * DM + 256 + m * 64 + lane] = (hf)(o[m] * rsqrtf(ss[m] * (1.f / 64.f) + 1e-6f) * nw * siluf_((float)zz[u][m])); } }
}

__device__ __forceinline__ void phase_rwa(const int wvs, const Params& p, int layer) {
  const int lane = ltid(wvs) & 63, gw = lbid() * 8 + (ltid(wvs) >> 6);
  hf* P = (hf*)(p.ws + OFF_BIG); hf* RL1 = (hf*)(p.ws + OFF_RL1); hf* RL3 = (hf*)(p.ws + OFF_RL3); float* INVN = (float*)(p.ws + OFF_INVN);
  const float* mu = p.in[I_MU] + layer * 1536; const float* kkw = p.in[I_KK] + layer * 384;
  int t0, tq;
  if (gw < 768) { t0 = 3 * gw; tq = 3; } else if (gw < 1920) { t0 = 2304 + 11 * (gw - 768); tq = 11; } else { t0 = 14976 + 19 * (gw - 1920); tq = 19; }
#define RWA_NB(tok_, nb_) { const int b_ = (tok_) / TPB, pos_ = (tok_) - b_ * TPB; const int dsel = lane & 3; \
    if (pos_ < LCTX) { nb_ = (dsel & 1) == 0 ? (pos_ >= 1 ? (tok_) - 1 : -1) : (pos_ + 1 < LCTX ? (tok_) + 1 : -1); } \
    else { const int s_ = pos_ - LCTX, row_ = s_ >> 6, cx_ = s_ & 63; \
      nb_ = dsel == 0 ? (cx_ > 0 ? (tok_) - 1 : -1) : dsel == 1 ? (cx_ < 63 ? (tok_) + 1 : -1) : dsel == 2 ? (row_ > 0 ? (tok_) - 64 : -1) : (row_ < 63 ? (tok_) + 64 : -1); } }
#define RWA_LOAD(tok_, nb_, pv_, sv_) { const hf* pr_ = P + (size_t)(tok_) * PP + PC_RW; const hf* pn_ = P + (size_t)((nb_) < 0 ? (tok_) : (nb_)) * PP + PC_RW; \
    _Pragma("unroll") for (int m = 0; m < 24; ++m) { pv_[m] = pr_[lane + 64 * m]; sv_[m] = pn_[lane + 64 * m]; } }
  hf pv[24], sv[24]; int nb;
  RWA_NB(t0, nb) RWA_LOAD(t0, nb, pv, sv)
#pragma unroll 1
  for (int tok = t0; tok < t0 + tq; ++tok) {
    hf npv[24], nsv[24]; int nnb = -1;
    if (tok + 1 < t0 + tq) { RWA_NB(tok + 1, nnb) RWA_LOAD(tok + 1, nnb, npv, nsv) }
    float val[24];
#pragma unroll
    for (int m = 0; m < 24; ++m) { const int c = lane + 64 * m; const float a = (float)pv[m], s = nb < 0 ? 0.f : (float)sv[m]; val[m] = a + (s - a) * mu[c]; }
    float ss[6];
#pragma unroll
    for (int m = 6; m < 12; ++m) { const float kv = val[m] * kkw[lane + 64 * m - 384]; ss[m - 6] = wave_sum(kv * kv); }
#pragma unroll
    for (int m = 0; m < 24; ++m) { const int c = lane + 64 * m;
      if (m < 18) RL1[(size_t)tok * 1152 + c] = (hf)val[m]; else if (m < 22) P[(size_t)tok * PP + PC_RL2 + (c - 1152)] = (hf)val[m]; else RL3[(size_t)tok * 128 + (c - 1408)] = (hf)val[m]; }
    if (lane < 6) { float s = ss[0];
#pragma unroll
      for (int q = 1; q < 6; ++q) s = lane == q ? ss[q] : s;
      INVN[(size_t)tok * 6 + lane] = rsqrtf(s + 1e-6f); }
#pragma unroll
    for (int m = 0; m < 24; ++m) { pv[m] = npv[m]; sv[m] = nsv[m]; }
    nb = nnb;
  }
#undef RWA_NB
#undef RWA_LOAD
}
__device__ __forceinline__ void phase_rwb(const int wvs, const Params& p, LAS unsigned char* lds, int layer) {
  const int bid = lbid() + 120, tid = ltid(wvs), wv = tid >> 6, lane = tid & 63, fr = lane & 15, fq = lane >> 4;
  if (bid >= 256) return;
  hf* P = (hf*)(p.ws + OFF_BIG);
  const hf* wupT = (const hf*)(p.ws + OFF_SMALL + (size_t)layer * SZ_SMALL + SZ_GLUT); const hf* aupT = (const hf*)(p.ws + OFF_SMALL + (size_t)layer * SZ_SMALL + SZ_GLUT + SZ_WUPT);
  const size_t tok = (size_t)(bid - 120) * 128 + wv * 16 + fr;
#pragma unroll 1
  for (int d = 0; d < 2; ++d) {
    h8 bw[2], ba[2];
#pragma unroll
    for (int ks = 0; ks < 2; ++ks) { const h8 x = *(const h8*)(P + tok * PP + PC_RL2 + d * 64 + ks * 32 + fq * 8);
#pragma unroll
      for (int j = 0; j < 8; ++j) bw[ks][j] = (hf)tanhf_((float)x[j]);
      ba[ks] = *(const h8*)(P + tok * PP + PC_RL2 + 128 + d * 64 + ks * 32 + fq * 8); }
    { h8 sw[6], sa[6];
#pragma unroll
      for (int j = 0; j < 6; ++j) { const int idx = tid + 512 * j; const size_t wo = ((size_t)d * 384 + (idx >> 3)) * 64 + (idx & 7) * 8; sw[j] = *(const h8*)(wupT + wo); sa[j] = *(const h8*)(aupT + wo); }
      __syncthreads();
#pragma unroll
      for (int j = 0; j < 6; ++j) { const int idx = tid + 512 * j; *(LAS h8*)(lds + (idx >> 3) * 144 + (idx & 7) * 16) = sw[j]; *(LAS h8*)(lds + 55296 + (idx >> 3) * 144 + (idx & 7) * 16) = sa[j]; }
      __syncthreads(); }
    const float* w0 = p.in[I_W0] + (layer * 2 + d) * 384; const float* a0 = p.in[I_A0] + (layer * 2 + d) * 384;
#pragma unroll 2
    for (int nt = 0; nt < 24; ++nt) { f32x4 aw = {0.f, 0.f, 0.f, 0.f}, aa = {0.f, 0.f, 0.f, 0.f};
      const int n4 = nt * 16 + fq * 4; const f32x4 w04 = *(const f32x4*)(w0 + n4), a04 = *(const f32x4*)(a0 + n4);
#pragma unroll
      for (int ks = 0; ks < 2; ++ks) { aw = mfma16(*(const LAS h8*)(lds + (nt * 16 + fr) * 144 + ks * 64 + fq * 16), bw[ks], aw); aa = mfma16(*(const LAS h8*)(lds + 55296 + (nt * 16 + fr) * 144 + ks * 64 + fq * 16), ba[ks], aa); }
      h4 oe, oa;
#pragma unroll
      for (int r = 0; r < 4; ++r) { const float wl = -softplusf_(-(w04[r] + aw[r])) - 0.5f; oe[r] = (hf)__expf(wl); oa[r] = (hf)sigmoidf_(a04[r] + aa[r]); }
      *(h4*)(P + tok * PP + PC_EF + d * 384 + n4) = oe; *(h4*)(P + tok * PP + PC_AF + d * 384 + n4) = oa; }
  }
}
__device__ __forceinline__ void phase_rwc(const int wvs, const Params& p, LAS unsigned char* lds, int layer, int wg0) {
  const int wgi = lbid() - wg0; if (wgi < 0 || wgi >= NB * 48) return;
  const int tid = ltid(wvs), wv = tid >> 6, lane = tid & 63;
  const int qd = wgi / 48, chain = wgi - qd * 48, d = chain & 1, h = (chain >> 1) % 6, b = chain / 12; const int v0 = qd * 16;
  constexpr int BUFSZ = 5 * 8192 + 2048, NBLK = TPB / 32, YOFF = 2 * BUFSZ, YSZ = 32 * 16 * 16 * 4;
  hf* P = (hf*)(p.ws + OFF_BIG); const hf* RL = (const hf*)(p.ws + OFF_RL1); const float* INVN = (const float*)(p.ws + OFF_INVN);
  const size_t tb = (size_t)b * TPB;
#define RW_POS(s) ((d == 0) ? (s) : ((s) < LCTX ? (LCTX - 1 - (s)) : (TPB + LCTX - 1 - (s))))
  if (wv >= 4) {
    const int pt = tid - 256;
    h4 nr[2], nk[2], ne[2], na[2]; float ninv[2]; h2 nv;
    f32x4 kkw[2], kaw[2];
#pragma unroll
    for (int j = 0; j < 2; ++j) { const int kg = (pt + 256 * j) & 15; kkw[j] = *(const f32x4*)(p.in[I_KK] + layer * 384 + h * 64 + kg * 4); kaw[j] = *(const f32x4*)(p.in[I_KA] + layer * 384 + h * 64 + kg * 4); }
    hf* ybase; long ypitch;
    if (d == 0) { ybase = (hf*)(p.ws + OFF_GV) + h * 64 + v0; ypitch = 384; }
    else if (h < 4) { ybase = P + PC_RL2 + h * 64 + v0; ypitch = PP; }
    else { ybase = (hf*)(p.ws + OFF_YB2) + (h - 4) * 64 + v0; ypitch = 128; }
#define RW_LOAD(blk) { _Pragma("unroll") for (int j = 0; j < 2; ++j) { const int it = pt + 256 * j, tt = it >> 4, k4 = (it & 15) * 4; const size_t tk = tb + RW_POS((blk) * 32 + tt); \
      nr[j] = *(const h4*)(RL + tk * 1152 + h * 64 + k4); nk[j] = *(const h4*)(RL + tk * 1152 + 384 + h * 64 + k4); \
      ne[j] = *(const h4*)(P + tk * PP + PC_EF + d * 384 + h * 64 + k4); na[j] = *(const h4*)(P + tk * PP + PC_AF + d * 384 + h * 64 + k4); ninv[j] = INVN[tk * 6 + h]; } \
      { const size_t tk = tb + RW_POS((blk) * 32 + (pt >> 3)); nv = *(const h2*)(RL + tk * 1152 + 768 + h * 64 + v0 + (pt & 7) * 2); } }
#define RW_DERIVE(bufi) { LAS float* Wv = (LAS float*)(lds + (bufi) * BUFSZ); LAS float* KKv = Wv + 2048; LAS float* Bv = KKv + 2048; LAS float* KDv = Bv + 2048; LAS float* Rv = KDv + 2048; LAS float* Vv = Rv + 2048; \
      _Pragma("unroll") for (int j = 0; j < 2; ++j) { const int it = pt + 256 * j, tt = it >> 4, k4 = (it & 15) * 4; f32x4 w4, kk4, b4, kd4, r4; \
        _Pragma("unroll") for (int q = 0; q < 4; ++q) { const float kf = (float)nk[j][q], a = (float)na[j][q]; w4[q] = __expf(-(float)ne[j][q]); const float kk = kf * kkw[j][q] * ninv[j]; kk4[q] = kk; b4[q] = -(kk * a); kd4[q] = kf * (1.f + (a - 1.f) * kaw[j][q]); r4[q] = (float)nr[j][q]; } \
        *(LAS f32x4*)(Wv + tt * 64 + k4) = w4; *(LAS f32x4*)(KKv + tt * 64 + k4) = kk4; *(LAS f32x4*)(Bv + tt * 64 + k4) = b4; *(LAS f32x4*)(KDv + tt * 64 + k4) = kd4; *(LAS f32x4*)(Rv + tt * 64 + k4) = r4; } \
      Vv[(pt >> 3) * 16 + (pt & 7) * 2] = (float)nv[0]; Vv[(pt >> 3) * 16 + (pt & 7) * 2 + 1] = (float)nv[1]; }
#define RW_YOUT(yb) { const LAS float* yp_ = (const LAS float*)(lds + YOFF + ((yb) & 1) * YSZ); _Pragma("unroll") for (int j = 0; j < 2; ++j) { const int o = pt + 256 * j, t_ = o >> 4, row = o & 15; \
      const f32x4 a0 = *(const LAS f32x4*)(yp_ + o * 16), a1 = *(const LAS f32x4*)(yp_ + o * 16 + 4), a2 = *(const LAS f32x4*)(yp_ + o * 16 + 8), a3 = *(const LAS f32x4*)(yp_ + o * 16 + 12); \
      const f32x4 s4 = (a0 + a1) + (a2 + a3); const float y = (s4[0] + s4[1]) + (s4[2] + s4[3]); \
      ybase[(long)(tb + RW_POS((yb) * 32 + t_)) * ypitch + row] = (hf)y; } }
    RW_LOAD(0) RW_DERIVE(0) RW_LOAD(1)
    __syncthreads();
#pragma unroll 2
    for (int blk = 0; blk < NBLK; ++blk) {
      if (blk + 1 < NBLK) RW_DERIVE((blk + 1) & 1)
      if (blk + 2 < NBLK) RW_LOAD(blk + 2)
      if (blk >= 1) RW_YOUT(blk - 1)
      __syncthreads();
    }
    RW_YOUT(NBLK - 1)
#undef RW_LOAD
#undef RW_DERIVE
#undef RW_YOUT
  } else {
    const int rowl = wv * 4 + (lane >> 4), kg = lane & 15;
    f32x4 S = {0.f, 0.f, 0.f, 0.f};
    __syncthreads();
#pragma unroll 2
    for (int blk = 0; blk < NBLK; ++blk) {
      LAS float* Wv = (LAS float*)(lds + (blk & 1) * BUFSZ) + kg * 4; LAS float* Vv = (LAS float*)(lds + (blk & 1) * BUFSZ) + 5 * 2048 + rowl;
      LAS float* ypw = (LAS float*)(lds + YOFF + (blk & 1) * YSZ) + rowl * 16 + kg;
      asm volatile("" : "+v"(Wv), "+v"(Vv), "+v"(ypw));
      f32x4 w4 = *(const LAS f32x4*)(Wv), kk4 = *(const LAS f32x4*)(Wv + 2048), b4 = *(const LAS f32x4*)(Wv + 4096), kd4 = *(const LAS f32x4*)(Wv + 6144), r4 = *(const LAS f32x4*)(Wv + 8192); float vv = Vv[0];
      f32x4 xw4 = *(const LAS f32x4*)(Wv + 64), xkk4 = *(const LAS f32x4*)(Wv + 2048 + 64), xb4 = *(const LAS f32x4*)(Wv + 4096 + 64), xkd4 = *(const LAS f32x4*)(Wv + 6144 + 64), xr4 = *(const LAS f32x4*)(Wv + 8192 + 64); float xvv = Vv[16];
#pragma unroll 16
      for (int t = 0; t < 32; ++t) {
        const int tn = t + 2;
        const f32x4 nw4 = *(const LAS f32x4*)(Wv + tn * 64), nkk4 = *(const LAS f32x4*)(Wv + 2048 + tn * 64), nb4 = *(const LAS f32x4*)(Wv + 4096 + tn * 64), nkd4 = *(const LAS f32x4*)(Wv + 6144 + tn * 64), nr4 = *(const LAS f32x4*)(Wv + 8192 + tn * 64);
        const float nvv = Vv[tn * 16];
        const f32x4 pa = S * kk4;
        const f32x4 t1 = S * w4 + vv * kd4;
        float sa = (pa[0] + pa[2]) + (pa[1] + pa[3]);
        sa = row16_sum(sa);
        S = t1 + sa * b4;
        const f32x4 py = S * r4;
        ypw[t * 256] = (py[0] + py[2]) + (py[1] + py[3]);
        w4 = xw4; kk4 = xkk4; b4 = xb4; kd4 = xkd4; r4 = xr4; vv = xvv;
        xw4 = nw4; xkk4 = nkk4; xb4 = nb4; xkd4 = nkd4; xr4 = nr4; xvv = nvv;
      }
      __syncthreads();
    }
  }
#undef RW_POS
}
__device__ __forceinline__ void phase_rwd(const int wvs, const Params& p, int layer) {
  const int lane = ltid(wvs) & 63, gw = lbid() * 8 + (ltid(wvs) >> 6), fr = lane & 15, fq = lane >> 4;
  const hf* P = (const hf*)(p.ws + OFF_BIG); const hf* RL = (const hf*)(p.ws + OFF_RL1); const hf* RL3 = (const hf*)(p.ws + OFF_RL3); hf* Y = (hf*)(p.ws + OFF_AY);
  const hf* gupT = (const hf*)(p.ws + OFF_SMALL + (size_t)layer * SZ_SMALL + SZ_GLUT + 2 * SZ_WUPT);
  for (int task = gw; task < (NTOK / 16) * 6; task += NWAVES) { const int h = task % 6; const size_t tok = (size_t)(task / 6) * 16 + fr;
    h8 bg[4];
#pragma unroll
    for (int ks = 0; ks < 4; ++ks) { const h8 x = *(const h8*)(RL3 + tok * 128 + ks * 32 + fq * 8);
#pragma unroll
      for (int j = 0; j < 8; ++j) bg[ks][j] = (hf)sigmoidf_((float)x[j]); }
    f32x4 gate[4]; float y[4][4]; float ssum = 0.f, bon = 0.f; h4 vv[4];
#pragma unroll
    for (int nt = 0; nt < 4; ++nt) { f32x4 acc = {0.f, 0.f, 0.f, 0.f};
#pragma unroll
      for (int ks = 0; ks < 4; ++ks) acc = mfma16(*(const h8*)(gupT + (size_t)(h * 64 + nt * 16 + fr) * 128 + ks * 32 + fq * 8), bg[ks], acc);
      gate[nt] = acc; const int ch = h * 64 + nt * 16 + fq * 4;
      const h4 yf = *(const h4*)((const hf*)(p.ws + OFF_GV) + tok * 384 + ch), yb = h < 4 ? *(const h4*)(P + tok * PP + PC_RL2 + ch) : *(const h4*)((const hf*)(p.ws + OFF_YB2) + tok * 128 + ch - 256), rr = *(const h4*)(RL + tok * 1152 + ch), kk = *(const h4*)(RL + tok * 1152 + 384 + ch);
      const h4 af = *(const h4*)(P + tok * PP + PC_AF + ch), ab = *(const h4*)(P + tok * PP + PC_AF + 384 + ch); vv[nt] = *(const h4*)(RL + tok * 1152 + 768 + ch);
      const f32x4 ka4 = *(const f32x4*)(p.in[I_KA] + layer * 384 + ch), rk4 = *(const f32x4*)(p.in[I_RK] + layer * 384 + ch);
#pragma unroll
      for (int r = 0; r < 4; ++r) { y[nt][r] = (float)yf[r] + (float)yb[r]; ssum += y[nt][r]; const float kf = (float)kk[r];
        bon += (float)rr[r] * rk4[r] * (kf * (1.f + ((float)af[r] - 1.f) * ka4[r]) + kf * (1.f + ((float)ab[r] - 1.f) * ka4[r])); } }
    ssum += __shfl_xor(ssum, 16); ssum += __shfl_xor(ssum, 32); bon += __shfl_xor(bon, 16); bon += __shfl_xor(bon, 32);
    const float mean = ssum * (1.f / 64.f); float vs = 0.f;
#pragma unroll
    for (int nt = 0; nt < 4; ++nt)
#pragma unroll
      for (int r = 0; r < 4; ++r) { const float dl = y[nt][r] - mean; vs += dl * dl; }
    vs += __shfl_xor(vs, 16); vs += __shfl_xor(vs, 32); const float rstd = rsqrtf(vs * (1.f / 64.f) + 64e-5f);
#pragma unroll
    for (int nt = 0; nt < 4; ++nt) { const int ch = h * 64 + nt * 16 + fq * 4; const f32x4 lw = *(const f32x4*)(p.in[I_LNW] + layer * 384 + ch), lb = *(const f32x4*)(p.in[I_LNB] + layer * 384 + ch); h4 o;
#pragma unroll
      for (int r = 0; r < 4; ++r) o[r] = (hf)((((y[nt][r] - mean) * rstd) * lw[r] + lb[r] + bon * (float)vv[nt][r]) * gate[nt][r]);
      *(h4*)(Y + tok * DM + 640 + ch) = o; }
  }
}

__device__ __forceinline__ void phase_x5(const int wvs, const Params& p, int layer) {
  const int lane = ltid(wvs) & 63, gw = lbid() * 8 + (ltid(wvs) >> 6), fr = lane & 15, fq = lane >> 4;
  const hf* P = (const hf*)(p.ws + OFF_BIG); const hf* RL = (const hf*)(p.ws + OFF_RL1); const hf* RL3 = (const hf*)(p.ws + OFF_RL3); hf* Y = (hf*)(p.ws + OFF_AY);
  const hf* gupT = (const hf*)(p.ws + OFF_SMALL + (size_t)layer * SZ_SMALL + SZ_GLUT + 2 * SZ_WUPT);
  const hf* Pg = (const hf*)(p.ws + OFF_BIG); const float nwg_ = p.in[I_GNORM][layer * 64 + lane];
  const int gwr = NWAVES - 1 - gw;
#pragma unroll 1
  for (int it = 0; it < 5; ++it) {
    const int tok0 = (gwr + it * NWAVES) * 2; const bool gv_ = tok0 < NTOK;
    hf ga[2][6], gb[2][6], gz[2][6];
    if (gv_) {
#pragma unroll
      for (int u = 0; u < 2; ++u) { const hf* pr = Pg + (size_t)(tok0 + u) * PP;
#pragma unroll
        for (int m = 0; m < 6; ++m) { ga[u][m] = pr[PC_GQ + m * 64 + lane]; gb[u][m] = pr[PC_GV + m * 64 + lane]; gz[u][m] = pr[PC_GZ + m * 64 + lane]; } } }
    const int task = gwr + it * NWAVES;
    if (task < (NTOK / 16) * 6) { const int h = task % 6; const size_t tok = (size_t)(task / 6) * 16 + fr;
    h8 bg[4];
#pragma unroll
    for (int ks = 0; ks < 4; ++ks) { const h8 x = *(const h8*)(RL3 + tok * 128 + ks * 32 + fq * 8);
#pragma unroll
      for (int j = 0; j < 8; ++j) bg[ks][j] = (hf)sigmoidf_((float)x[j]); }
    f32x4 gate[4]; float y[4][4]; float ssum = 0.f, bon = 0.f; h4 vv[4];
#pragma unroll
    for (int nt = 0; nt < 4; ++nt) { f32x4 acc = {0.f, 0.f, 0.f, 0.f};
#pragma unroll
      for (int ks = 0; ks < 4; ++ks) acc = mfma16(*(const h8*)(gupT + (size_t)(h * 64 + nt * 16 + fr) * 128 + ks * 32 + fq * 8), bg[ks], acc);
      gate[nt] = acc; const int ch = h * 64 + nt * 16 + fq * 4;
      const h4 yf = *(const h4*)((const hf*)(p.ws + OFF_GV) + tok * 384 + ch), yb = h < 4 ? *(const h4*)(P + tok * PP + PC_RL2 + ch) : *(const h4*)((const hf*)(p.ws + OFF_YB2) + tok * 128 + ch - 256), rr = *(const h4*)(RL + tok * 1152 + ch), kk = *(const h4*)(RL + tok * 1152 + 384 + ch);
      const h4 af = *(const h4*)(P + tok * PP + PC_AF + ch), ab = *(const h4*)(P + tok * PP + PC_AF + 384 + ch); vv[nt] = *(const h4*)(RL + tok * 1152 + 768 + ch);
      const f32x4 ka4 = *(const f32x4*)(p.in[I_KA] + layer * 384 + ch), rk4 = *(const f32x4*)(p.in[I_RK] + layer * 384 + ch);
#pragma unroll
      for (int r = 0; r < 4; ++r) { y[nt][r] = (float)yf[r] + (float)yb[r]; ssum += y[nt][r]; const float kf = (float)kk[r];
        bon += (float)rr[r] * rk4[r] * (kf * (1.f + ((float)af[r] - 1.f) * ka4[r]) + kf * (1.f + ((float)ab[r] - 1.f) * ka4[r])); } }
    ssum += __shfl_xor(ssum, 16); ssum += __shfl_xor(ssum, 32); bon += __shfl_xor(bon, 16); bon += __shfl_xor(bon, 32);
    const float mean = ssum * (1.f / 64.f); float vs = 0.f;
#pragma unroll
    for (int nt = 0; nt < 4; ++nt)
#pragma unroll
      for (int r = 0; r < 4; ++r) { const float dl = y[nt][r] - mean; vs += dl * dl; }
    vs += __shfl_xor(vs, 16); vs += __shfl_xor(vs, 32); const float rstd = rsqrtf(vs * (1.f / 64.f) + 64e-5f);
#pragma unroll
    for (int nt = 0; nt < 4; ++nt) { const int ch = h * 64 + nt * 16 + fq * 4; const f32x4 lw = *(const f32x4*)(p.in[I_LNW] + layer * 384 + ch), lb = *(const f32x4*)(p.in[I_LNB] + layer * 384 + ch); h4 o;
#pragma unroll
      for (int r = 0; r < 4; ++r) o[r] = (hf)((((y[nt][r] - mean) * rstd) * lw[r] + lb[r] + bon * (float)vv[nt][r]) * gate[nt][r]);
      *(h4*)(Y + tok * DM + 640 + ch) = o; }
    }
    if (gv_) {
#pragma unroll
      for (int u = 0; u < 2; ++u) { float o[6], ss[6];
#pragma unroll
        for (int m = 0; m < 6; ++m) { o[m] = (float)ga[u][m] + (float)gb[u][m]; ss[m] = wave_sum(o[m] * o[m]); }
#pragma unroll
        for (int m = 0; m < 6; ++m) Y[(size_t)(tok0 + u) * DM + 256 + m * 64 + lane] = (hf)(o[m] * rsqrtf(ss[m] * (1.f / 64.f) + 1e-6f) * nwg_ * siluf_((float)gz[u][m])); } }
  }
}

__global__ void __launch_bounds__(512) mega(Params p_unused) {
  extern __shared__ __attribute__((aligned(16))) unsigned char lds_raw[];
  LAS unsigned char* lds = (LAS unsigned char*)lds_raw;
  cg::grid_group grid = cg::this_grid();
  const int wvs = __builtin_amdgcn_readfirstlane((int)__builtin_amdgcn_workitem_id_x() >> 6);
  { const Params p = load_params(); const int tid = ltid(wvs);
    if (lbid() == 0) { unsigned* bar = (unsigned*)(p.ws + OFF_BAR); for (int i = tid; i < XCD_BAR_WORDS; i += 512) bar[i] = 0u; }
    if (tid < 4) ((LAS unsigned*)(lds + LDS_ST_OFF))[tid] = 0u; }
  { const Params p = load_params(); phase0a(wvs, p, lds); }
  { const Params p = load_params(); phase_convert(wvs, p, lds, 0, 0); }
  grid.sync();
  xcd_post(wvs);
  { const Params p = load_params(); phase0b(wvs, p); phase0b_local(wvs, p); }
  gsync(wvs, lds);
#pragma unroll 1
  for (int layer = 0; layer < 2; ++layer) {
    if (layer > 0) { const Params p = load_params(); phase_convert(wvs, p, lds, layer, 0); }
    { const Params p = load_params(); phase_prenorm(wvs, p, layer, 0, layer == 0 ? p.in[I_X] : p.out, layer == 0 ? p.in[I_CTX] : (const float*)(p.ws + OFF_XCTX), layer == 1); }
    gsync(wvs, lds);
    { const Params p = load_params(); pg8::StaticOrder so; pg8::Gemm g{(const hf*)(p.ws + OFF_AY), (const hf*)(p.ws + OFF_WIN), NTOK, PP, DM, DM}; so.init(NTOK, PP, NWG, lbid()); pg8::EpiF16<0> e{}; pg8::gemm_phase(wvs, lds, g, so, e); }
    gsync(wvs, lds);
    { const Params p = load_params(); phase_x1(wvs, p, lds, layer); }
    gsync(wvs, lds);
    { const Params p = load_params(); phase_s5b(wvs, p, layer, 240); }
    { const Params p = load_params(); phase_gdb(wvs, p, lds, 240); }
    { const Params p = load_params(); phase_rwa(wvs, p, layer); }
    gsync(wvs, lds);
    { const Params p = load_params(); phase_rwb(wvs, p, lds, layer); }
    gsync(wvs, lds);
    { const Params p = load_params(); phase_gdc(wvs, p, lds, 0); }
    { const Params p = load_params(); phase_rwc(wvs, p, lds, layer, 48); }
    if (lbid() >= 240) { const Params p = load_params(); for (int cs = 0; cs < 9; ++cs) s5c_wg(wvs, p, lds, layer, (lbid() - 240) + 16 * cs); }
    gsync(wvs, lds);
    { const Params p = load_params(); if (lbid() < 136) s5d_wg(wvs, p, lds, layer, lbid()); }
    { const Params p = load_params(); phase_x5(wvs, p, layer); }
    gsync(wvs, lds);
    { const Params p = load_params(); pg8::StaticOrder so;
      pg8::Gemm g{(const hf*)(p.ws + OFF_AY), (const hf*)(p.ws + OFF_WOUT), NTOK, DM, DM, DM}; so.init(NTOK, DM, NWG, lbid(), true);
      pg8::EpiRes e{layer, 0, false}; pg8::gemm_phase(wvs, lds, g, so, e); }
    if (layer == 0) { const Params p = load_params(); pg8::StaticOrder so;
      pg8::Gemm g{(const hf*)(p.ws + OFF_AY), (const hf*)(p.ws + OFF_WOUT), NTOK, DM, 256, DM}; so.init_ctxsplit(DM, NWG, lbid(), 4, 256);
      pg8::EpiPart e{OFF_RI, 256}; pg8::gemm_phase(wvs, lds, g, so, e); }
    gsync(wvs, lds);
    { const Params p = load_params(); phase_convert(wvs, p, lds, layer, 1); }
    { const Params p = load_params(); phase_prenorm(wvs, p, layer, 1, p.out, layer == 0 ? p.in[I_CTX] : (const float*)(p.ws + OFF_XCTX), layer == 0); }
    gsync(wvs, lds);
    { const Params p = load_params(); pg8::StaticOrder so; pg8::Gemm g{(const hf*)(p.ws + OFF_AY), (const hf*)(p.ws + OFF_W1), NTOK, DFF, DM, DM}; so.init(NTOK, DFF, NWG, lbid(), layer == 1); pg8::EpiF16<1> e{}; pg8::gemm_phase(wvs, lds, g, so, e); }
    gsync(wvs, lds);
    { const Params p = load_params(); pg8::StaticOrder so;
      pg8::Gemm g{(const hf*)(p.ws + OFF_BIG), (const hf*)(p.ws + OFF_W2), NTOK, DM, DFF, DFF}; so.init(NTOK, DM, NWG, lbid(), true);
      pg8::EpiRes e{layer, 1, false}; pg8::gemm_phase(wvs, lds, g, so, e); }
    if (layer == 0) { const Params p = load_params(); pg8::StaticOrder so;
      pg8::Gemm g{(const hf*)(p.ws + OFF_BIG), (const hf*)(p.ws + OFF_W2), NTOK, DM, 1024, DFF}; so.init_ctxsplit(DM, NWG, lbid(), 4, 1024);
      pg8::EpiPart e{OFF_RI, 1024}; pg8::gemm_phase(wvs, lds, g, so, e); }
    gsync(wvs, lds);
  }
  { const Params p = load_params(); phase_final(wvs, p); }
}

extern "C" void kernel_launch(void* const* d_in, const int* in_sizes, int n_in, void* d_out, int out_size, void* d_ws, size_t ws_size, hipStream_t stream) {
  constexpr size_t kDynLds = 156 * 1024;
  static int grid_blocks = 0;
  if (!grid_blocks) {
    int dev = 0, cus = 0, per_cu = 0;
    (void)hipGetDevice(&dev);
    (void)hipDeviceGetAttribute(&cus, hipDeviceAttributeMultiprocessorCount, dev);
    (void)hipFuncSetAttribute((const void*)mega, hipFuncAttributeMaxDynamicSharedMemorySize, (int)kDynLds);
    (void)hipOccupancyMaxActiveBlocksPerMultiprocessor(&per_cu, (const void*)mega, 512, kDynLds);
    grid_blocks = NWG;
    if (cus != NWG || per_cu < 1 || ws_size < WS_NEED || n_in != 38) { fprintf(stderr, "kernel_launch: unexpected configuration: cus %d per_cu %d ws %zu n_in %d\n", cus, per_cu, ws_size, n_in); }
  }
  if (ws_size < WS_NEED || n_in != 38) return;
  Params p{};
  for (int i = 0; i < 38; ++i) p.in[i] = (const float*)d_in[i];
  p.out = (float*)d_out; p.ws = (unsigned char*)d_ws;
  void* args[] = {&p};
  hipError_t e = hipLaunchCooperativeKernel((void*)mega, dim3(grid_blocks), dim3(512), args, kDynLds, stream);
  if (e != hipSuccess) fprintf(stderr, "cooperative launch failed: %s (grid %d)\n", hipGetErrorString(e), grid_blocks);
}
```
